# Optimizing an MI355X kernel written in HIP

```python
import math
import jax, jax.numpy as jnp
from jax import lax
import numpy as np

D_MODEL = 1024
BATCH = 2
SEQ = 8192
DEPTH = 2
DEC_BATCH = 8
DEC_SEQ = 4096
PAST_LEN = 128

PLE_DIM = 256
MIX_WIDTH = 2 * D_MODEL
S5_WIDTH = D_MODEL
S5_GROUP = 16
S5_GROUPS = S5_WIDTH // S5_GROUP
S5_STATE = 64
S5_DT_MIN = 1e-3
S5_DT_MAX = 1e-1
MLA_HEADS = 8
MLA_NOPE = 128
MLA_ROPE = 64
MLA_QK = MLA_NOPE + MLA_ROPE
MLA_V = 128
MLA_Q_RANK = 384
MLA_KV_RANK = 256
MLA_WIDTH = MLA_HEADS * MLA_V
ROPE_THETA = 10000.0
Q_BLOCK = 128
AB_SPLITS = [S5_WIDTH, S5_WIDTH + MLA_Q_RANK, S5_WIDTH + MLA_Q_RANK + MLA_KV_RANK, S5_WIDTH + MLA_Q_RANK + MLA_KV_RANK + MLA_ROPE]
AB_IN = AB_SPLITS[-1] + MIX_WIDTH
HY_WIDTH = MIX_WIDTH
HY_IN = 4 * HY_WIDTH
HY_EMB = 33
HY_BANDS = (HY_EMB - 1) // 2
HY_ORDER = 64
HY_DECAY_TARGET = 1e-2
HY_FAST_PCT = 0.3
HY_SLOW_PCT = 1.5
N_AB = (DEPTH + 1) // 2
N_HY = DEPTH // 2
EPS = 1e-6

kernel_name = 'hybrid_s5_mla_hyena_encoder'


def rms_norm(x, g):
    xf = x.astype(jnp.float32)
    y = xf * lax.rsqrt(jnp.mean(xf * xf, axis=-1, keepdims=True) + EPS)
    return (y * g.astype(jnp.float32)).astype(x.dtype)


def _ssm_combine(left, right):
    a_l, b_l = left
    a_r, b_r = right
    return a_l * a_r, a_r * b_l + b_r


def s5_direction(u_groups, a_re, a_im, log_dt, b_re, b_im, c_re, c_im, reverse):
    f32 = jnp.float32
    lam = lax.complex(a_re.astype(f32), a_im.astype(f32))
    dt = jnp.exp(log_dt.astype(f32))[:, None]
    a_bar = jnp.exp(lam * dt)
    b = lax.complex(b_re.astype(f32), b_im.astype(f32))
    b_bar = ((a_bar - 1.0) / lam)[:, :, None] * b
    c = lax.complex(c_re.astype(f32), c_im.astype(f32))
    bu = jnp.einsum('blgc,gnc->blgn', u_groups.astype(jnp.complex64), b_bar)
    a_seq = jnp.broadcast_to(a_bar, (1, u_groups.shape[1]) + a_bar.shape)
    _, states = lax.associative_scan(_ssm_combine, (a_seq, bu), reverse=reverse, axis=1)
    return jnp.real(jnp.einsum('blgn,gcn->blgc', states, c))


def s5_mixer(u, a_re, a_im, log_dt, b_re, b_im, c_re, c_im, d, glu_w, glu_b):
    bsz, seq_len, _ = u.shape
    uf = u.astype(jnp.float32)
    ug = uf.reshape(bsz, seq_len, S5_GROUPS, S5_GROUP)
    y_fwd = s5_direction(ug, a_re[0], a_im[0], log_dt[0], b_re[0], b_im[0], c_re[0], c_im[0], False)
    y_bwd = s5_direction(ug, a_re[1], a_im[1], log_dt[1], b_re[1], b_im[1], c_re[1], c_im[1], True)
    y = (y_fwd + y_bwd).reshape(bsz, seq_len, S5_WIDTH) + d.astype(jnp.float32) * uf
    y = jax.nn.gelu(y).astype(u.dtype)
    return y * jax.nn.sigmoid(y @ glu_w + glu_b)


def rope_tables(seq_len):
    inv = 1.0 / (ROPE_THETA ** (jnp.arange(0, MLA_ROPE, 2, dtype=jnp.float32) / MLA_ROPE))
    ang = jnp.arange(seq_len, dtype=jnp.float32)[:, None] * inv[None, :]
    return jnp.cos(ang), jnp.sin(ang)


def apply_rope(x, cos, sin):
    half = MLA_ROPE // 2
    xf = x.astype(jnp.float32)
    x1, x2 = xf[..., :half], xf[..., half:]
    return jnp.concatenate([x1 * cos - x2 * sin, x1 * sin + x2 * cos], axis=-1).astype(x.dtype)


def mla_mixer(q_lat, kv_lat, k_rope, q_norm, w_q_up, kv_norm, w_kv_up):
    bsz, seq_len, _ = q_lat.shape
    q = (rms_norm(q_lat, q_norm) @ w_q_up).reshape(bsz, seq_len, MLA_HEADS, MLA_QK)
    kv = (rms_norm(kv_lat, kv_norm) @ w_kv_up).reshape(bsz, seq_len, MLA_HEADS, MLA_NOPE + MLA_V)
    q_nope, q_rope = q[..., :MLA_NOPE], q[..., MLA_NOPE:]
    k_nope, v = kv[..., :MLA_NOPE], kv[..., MLA_NOPE:]
    cos, sin = rope_tables(seq_len)
    q_rope = apply_rope(q_rope, cos[:, None, :], sin[:, None, :])
    k_rope = apply_rope(k_rope, cos, sin)
    n_blocks = seq_len // Q_BLOCK
    scale = MLA_QK ** -0.5

    def to_blocks(t):
        return t.reshape((bsz, n_blocks, Q_BLOCK) + t.shape[2:]).swapaxes(0, 1)

    def attend(blk):
        qn, qr = blk
        s = jnp.einsum('bqhd,bkhd->bhqk', qn, k_nope) + jnp.einsum('bqhr,bkr->bhqk', qr, k_rope)
        p = jax.nn.softmax(s.astype(jnp.float32) * scale, axis=-1).astype(v.dtype)
        return jnp.einsum('bhqk,bkhd->bqhd', p, v)

    o = lax.map(attend, (to_blocks(q_nope), to_blocks(q_rope)))
    return o.swapaxes(0, 1).reshape(bsz, seq_len, MLA_WIDTH)


def hyena_filter(seq_len, w1, b1, f1, w2, b2, f2, w3):
    f32 = jnp.float32
    t = jnp.linspace(0.0, 1.0, seq_len, dtype=f32)[:, None]
    w = 2.0 * math.pi * jnp.arange(seq_len, dtype=f32)[:, None] / seq_len
    bands = jnp.linspace(1e-4, HY_BANDS - 1, HY_BANDS, dtype=f32)[None, :]
    z = jnp.concatenate([t, jnp.cos(bands * w), -jnp.sin(bands * w)], axis=-1)
    h = jnp.sin(f1.astype(f32) * (z @ w1.astype(f32) + b1.astype(f32)))
    h = jnp.sin(f2.astype(f32) * (h @ w2.astype(f32) + b2.astype(f32)))
    h = h @ w3.astype(f32)
    min_decay = math.log(HY_DECAY_TARGET) / HY_SLOW_PCT
    max_decay = math.log(HY_DECAY_TARGET) / HY_FAST_PCT
    deltas = jnp.abs(jnp.linspace(min_decay, max_decay, HY_WIDTH, dtype=f32))
    return h * jnp.exp(-t * deltas[None, :])


def hyena_mixer(xv, conv_w, conv_b, f_w1, f_b1, f_freq1, f_w2, f_b2, f_freq2, f_w3, bias):
    bsz, seq_len, _ = xv.shape
    xp = jnp.pad(xv, ((0, 0), (1, 1), (0, 0)))
    uc = xp[:, :-2] * conv_w[0] + xp[:, 1:-1] * conv_w[1] + xp[:, 2:] * conv_w[2] + conv_b
    x0, x1, v = jnp.split(uc, 3, axis=-1)
    k_fwd = hyena_filter(seq_len, f_w1[0], f_b1[0], f_freq1[0], f_w2[0], f_b2[0], f_freq2[0], f_w3[0])
    k_bwd = hyena_filter(seq_len, f_w1[1], f_b1[1], f_freq1[1], f_w2[1], f_b2[1], f_freq2[1], f_w3[1])
    k_two = jnp.concatenate([k_fwd, jnp.zeros((1, HY_WIDTH), jnp.float32), k_bwd[:0:-1]], axis=0)
    k_two = k_two * lax.rsqrt(jnp.sum(k_two * k_two, axis=0, keepdims=True) + EPS)
    vx = (v * x1).astype(jnp.float32)
    n_fft = 2 * seq_len
    conv = jnp.fft.irfft(jnp.fft.rfft(vx, n=n_fft, axis=1) * jnp.fft.rfft(k_two, n=n_fft, axis=0)[None], n=n_fft, axis=1)[:, :seq_len]
    y = (conv + vx * bias.astype(jnp.float32)) * x0.astype(jnp.float32)
    return y.astype(xv.dtype)


def setup_inputs(seed: int = 0) -> dict:
    key = jax.random.key(seed)
    ks = iter(jax.random.split(key, 48))
    f32 = jnp.float32

    def nrm(shape, scale=1.0):
        return scale * jax.random.normal(next(ks), shape, f32)

    def gain(shape):
        return 1.0 + 0.05 * jax.random.normal(next(ks), shape, f32)

    s5_ssm = (N_AB, 2, S5_GROUPS, S5_STATE)
    n_idx = jnp.arange(S5_STATE, dtype=f32)
    return {
        'x_prompt': nrm((BATCH, SEQ, D_MODEL)),
        'x_sample': nrm((DEC_BATCH, DEC_SEQ, D_MODEL)),
        'p_prompt': nrm((DEPTH, BATCH, SEQ, PLE_DIM)),
        'p_sample': nrm((DEPTH, DEC_BATCH, DEC_SEQ, PLE_DIM)),
        'norm_g': gain((DEPTH, D_MODEL)),
        'final_g': gain((D_MODEL,)),
        'ple_w': nrm((DEPTH, PLE_DIM, D_MODEL), PLE_DIM ** -0.5),
        'ple_gate_w': nrm((DEPTH, D_MODEL, D_MODEL), D_MODEL ** -0.5),
        'ab_w_in': nrm((N_AB, D_MODEL, AB_IN), D_MODEL ** -0.5),
        'ab_w_out': nrm((N_AB, MIX_WIDTH, D_MODEL), MIX_WIDTH ** -0.5),
        's5_a_re': -0.5 * jnp.exp(nrm(s5_ssm, 0.05)),
        's5_a_im': math.pi * n_idx + nrm(s5_ssm, 0.01),
        's5_log_dt': jax.random.uniform(next(ks), (N_AB, 2, S5_GROUPS), f32, math.log(S5_DT_MIN), math.log(S5_DT_MAX)),
        's5_b_re': nrm((N_AB, 2, S5_GROUPS, S5_STATE, S5_GROUP), (2 * S5_GROUP) ** -0.5),
        's5_b_im': nrm((N_AB, 2, S5_GROUPS, S5_STATE, S5_GROUP), (2 * S5_GROUP) ** -0.5),
        's5_c_re': nrm((N_AB, 2, S5_GROUPS, S5_GROUP, S5_STATE), 0.5),
        's5_c_im': nrm((N_AB, 2, S5_GROUPS, S5_GROUP, S5_STATE), 0.5),
        's5_d': nrm((N_AB, S5_WIDTH)),
        's5_glu_w': nrm((N_AB, S5_WIDTH, S5_WIDTH), S5_WIDTH ** -0.5),
        's5_glu_b': nrm((N_AB, S5_WIDTH), 0.01),
        'mla_q_norm': gain((N_AB, MLA_Q_RANK)),
        'mla_w_q_up': nrm((N_AB, MLA_Q_RANK, MLA_HEADS * MLA_QK), MLA_Q_RANK ** -0.5),
        'mla_kv_norm': gain((N_AB, MLA_KV_RANK)),
        'mla_w_kv_up': nrm((N_AB, MLA_KV_RANK, MLA_HEADS * (MLA_NOPE + MLA_V)), MLA_KV_RANK ** -0.5),
        'hy_w_in': nrm((N_HY, D_MODEL, HY_IN), D_MODEL ** -0.5),
        'hy_w_out': nrm((N_HY, HY_WIDTH, D_MODEL), HY_WIDTH ** -0.5),
        'hy_conv_w': nrm((N_HY, 3, 3 * HY_WIDTH), 3 ** -0.5),
        'hy_conv_b': nrm((N_HY, 3 * HY_WIDTH), 0.01),
        'hy_f_w1': nrm((N_HY, 2, HY_EMB, HY_ORDER), HY_EMB ** -0.5),
        'hy_f_b1': nrm((N_HY, 2, HY_ORDER), 0.01),
        'hy_f_freq1': gain((N_HY, 2, HY_ORDER)),
        'hy_f_w2': nrm((N_HY, 2, HY_ORDER, HY_ORDER), HY_ORDER ** -0.5),
        'hy_f_b2': nrm((N_HY, 2, HY_ORDER), 0.01),
        'hy_f_freq2': gain((N_HY, 2, HY_ORDER)),
        'hy_f_w3': nrm((N_HY, 2, HY_ORDER, HY_WIDTH), HY_ORDER ** -0.5),
        'hy_bias': nrm((N_HY, HY_WIDTH)),
    }


def reference(x_prompt, x_sample, p_prompt, p_sample, norm_g, final_g, ple_w, ple_gate_w,
              ab_w_in, ab_w_out, s5_a_re, s5_a_im, s5_log_dt, s5_b_re, s5_b_im, s5_c_re, s5_c_im,
              s5_d, s5_glu_w, s5_glu_b, mla_q_norm, mla_w_q_up, mla_kv_norm, mla_w_kv_up,
              hy_w_in, hy_w_out, hy_conv_w, hy_conv_b, hy_f_w1, hy_f_b1, hy_f_freq1,
              hy_f_w2, hy_f_b2, hy_f_freq2, hy_f_w3, hy_bias):
    def trunk(x, p):
        h = x
        for i in range(DEPTH):
            j = i // 2
            hn = rms_norm(h, norm_g[i])
            if i % 2 == 0:
                u_s5, q_lat, kv_lat, k_rope, gate = jnp.split(hn @ ab_w_in[j], AB_SPLITS, axis=-1)
                y_a = s5_mixer(u_s5, s5_a_re[j], s5_a_im[j], s5_log_dt[j], s5_b_re[j], s5_b_im[j],
                               s5_c_re[j], s5_c_im[j], s5_d[j], s5_glu_w[j], s5_glu_b[j])
                y_b = mla_mixer(q_lat, kv_lat, k_rope, mla_q_norm[j], mla_w_q_up[j], mla_kv_norm[j], mla_w_kv_up[j])
                y = jnp.concatenate([y_a, y_b], axis=-1)
                h = h + (y * jax.nn.silu(gate)) @ ab_w_out[j]
            else:
                z = hn @ hy_w_in[j]
                xv, gate = z[..., :3 * HY_WIDTH], z[..., 3 * HY_WIDTH:]
                y = hyena_mixer(xv, hy_conv_w[j], hy_conv_b[j], hy_f_w1[j], hy_f_b1[j], hy_f_freq1[j],
                                hy_f_w2[j], hy_f_b2[j], hy_f_freq2[j], hy_f_w3[j], hy_bias[j])
                h = h + (y * jax.nn.silu(gate)) @ hy_w_out[j]
            h = h + jax.nn.sigmoid(h @ ple_gate_w[i]) * (p[i] @ ple_w[i])
        return rms_norm(h, final_g)

    y_prompt = trunk(x_prompt, p_prompt)
    y_sample = trunk(x_sample, p_sample)
    return (y_prompt, y_sample)
```

```cpp
#include <hip/hip_runtime.h>
#include <hip/hip_bf16.h>
#include <hip/hip_cooperative_groups.h>
#include <cstdio>
#include <cmath>
namespace cg = cooperative_groups;

#define DI __device__ __forceinline__
typedef unsigned short bft;
using bf16x8 = __attribute__((ext_vector_type(8))) short;
using s16x4  = __attribute__((ext_vector_type(4))) short;
using f32x4  = __attribute__((ext_vector_type(4))) float;
using f32x16 = __attribute__((ext_vector_type(16))) float;
using u32x4  = __attribute__((ext_vector_type(4))) unsigned;
using u32x2  = __attribute__((ext_vector_type(2))) unsigned;

constexpr int T = 49152, TP = 16384, DM = 1024;
constexpr float EPS = 1e-6f;
constexpr int NTHR = 512;
constexpr size_t LDS_BYTES = 147456;

constexpr int LDP = 1088, LDW1 = 1088, LDW2 = 2112, LDWQ = 448, LDWS = 320;
constexpr size_t SZ_W0t = 3840ull * LDW1 * 2, SZ_Wq = 1536ull * LDWQ * 2, SZ_Wkv = 2048ull * LDWS * 2, SZ_Wsq = 1024ull * LDW1 * 2;
constexpr size_t SZ_Wout = 1024ull * LDW2 * 2, SZ_Wpw = 1024ull * LDWS * 2, SZ_W1t = 8192ull * LDW1 * 2;
constexpr size_t OFF_W0t = 0, OFF_Wq = OFF_W0t + SZ_W0t, OFF_Wkv = OFF_Wq + SZ_Wq, OFF_Wglu = OFF_Wkv + SZ_Wkv, OFF_Wout0 = OFF_Wglu + SZ_Wsq;
constexpr size_t OFF_Wpg = OFF_Wout0 + SZ_Wout, OFF_Wpw = OFF_Wpg + 2 * SZ_Wsq, OFF_W1t = OFF_Wpw + 2 * SZ_Wpw, OFF_Wout1 = OFF_W1t + SZ_W1t;
constexpr size_t OFF_R0 = OFF_Wout1 + SZ_Wout, OFF_SSQ1 = OFF_R0 + T * 4, OFF_SSQF = OFF_SSQ1 + T * 4, OFF_HYSSQ = OFF_SSQF + T * 4;
constexpr size_t OFF_ROPE = OFF_HYSSQ + 2 * 2048 * 4, OFF_H2 = OFF_ROPE + 8192ull * 64 * 4;
constexpr size_t SZ_H2 = (8192ull + 4096) * 2 * 64 * 4;
constexpr size_t OFF_A = (OFF_H2 + SZ_H2 + 255) / 256 * 256;
constexpr size_t SZ_TB = (size_t)T * 1024 * 2;
constexpr size_t OFF_U = OFF_A + (size_t)T * LDP * 2;
constexpr size_t OFF_LAT = OFF_U + SZ_TB;
constexpr size_t SZ_LAT = (size_t)T * 704 * 2;
constexpr size_t OFF_G0 = OFF_LAT + SZ_LAT;
constexpr size_t SZ_G0 = (size_t)T * 2048 * 2;
constexpr size_t WS_END = OFF_G0 + SZ_G0;
constexpr size_t OFF_KRAW = OFF_LAT + 32ull * 1024 * 1024, SZ_KRAW = (16384ull + 8192) * 256 * 4;
static_assert(OFF_KRAW + SZ_KRAW <= OFF_G0, "kraw fits in LAT region");
constexpr size_t OFF_KHAT = OFF_G0, SZ_KHAT = (16384ull + 8192) * 256 * 8;
constexpr size_t OFF_VXT = OFF_KHAT + SZ_KHAT, SZ_VXT = (size_t)T * 256 * 4;
constexpr size_t OFF_G1H = OFF_VXT + SZ_VXT, SZ_G1H = (size_t)T * 1024 * 2;
static_assert(OFF_G1H + SZ_G1H <= WS_END, "layer1 layout");
constexpr size_t OFF_HB3 = OFF_U;
constexpr size_t OFF_BAR = (WS_END + 255) / 256 * 256;
static_assert(OFF_BAR + 16384 <= 536870912ull, "workspace budget");

#define XB_TMO      128
#define XB_XCNT(j)  (256  + 64 * (j))
#define XB_XSUB(j)  (1280 + 64 * (j))
#define XB_XGEN(j)  (2304 + 64 * (j))
#define XB_TOP      3328
#define XB_TOPGEN   3392
#define XCD_BAR_WORDS 3456
#define XB_SPIN_CAP (1u << 22)
#define LAS __attribute__((address_space(3)))
__device__ __forceinline__ unsigned xb_ld(unsigned* p)              { return __hip_atomic_load(p, __ATOMIC_RELAXED, __HIP_MEMORY_SCOPE_AGENT); }
__device__ __forceinline__ unsigned xb_add(unsigned* p, unsigned v) { return __hip_atomic_fetch_add(p, v, __ATOMIC_RELAXED, __HIP_MEMORY_SCOPE_AGENT); }
__device__ __forceinline__ unsigned xb_xcc_id() { return (unsigned)__builtin_amdgcn_s_getreg((3 << 11) | 20) & 0xFu; }
#define XB_SPIN(cond, bar) do { unsigned _sp = 0; while (cond) { __builtin_amdgcn_s_sleep(1); \
    if ((++_sp & 255u) == 0u) { if (xb_ld(&(bar)[XB_TMO])) break; if (_sp > XB_SPIN_CAP) { atomicAdd(&(bar)[XB_TMO], 1u); break; } } } } while (0)
struct XcdBarrier { unsigned* bar; unsigned x; volatile LAS unsigned* st; };
__device__ __forceinline__ XcdBarrier xcd_barrier_post(unsigned* bar, volatile LAS unsigned* st) {
  XcdBarrier b; b.bar = bar; b.x = (unsigned)__builtin_amdgcn_readfirstlane((int)xb_xcc_id()); b.st = st;
  if (threadIdx.x == 0) st[2] = xb_add(&bar[XB_XCNT(b.x)], 1u);
  return b;
}
__device__ __forceinline__ void xcd_barrier_complete(unsigned* bar, unsigned x, unsigned& nloc, unsigned& nx) {
  const unsigned G = gridDim.x * gridDim.y * gridDim.z;
  unsigned sum, cnt, mine, sp = 0u;
  for (;;) {
    sum = 0u; cnt = 0u; mine = 0u;
#pragma unroll
    for (unsigned j = 0; j < 16; ++j) { const unsigned c = xb_ld(&bar[XB_XCNT(j)]); sum += c; cnt += (c > 0u) ? 1u : 0u; mine = (j == x) ? c : mine; }
    if (sum == G) break;
    __builtin_amdgcn_s_sleep(1);
    if ((++sp & 255u) == 0u) { if (xb_ld(&bar[XB_TMO])) break; if (sp > XB_SPIN_CAP) { atomicAdd(&bar[XB_TMO], 1u); break; } }
  }
  nloc = mine > 0u ? mine : 1u; nx = cnt > 0u ? cnt : 1u;
}
__device__ __forceinline__ void xcd_barrier(const XcdBarrier& b) {
  asm volatile("s_waitcnt vmcnt(0)" ::: "memory");
  __syncthreads();
  if (threadIdx.x == 0) {
    unsigned* bar = b.bar; unsigned bx = b.x; asm volatile("" : "+s"(bx));
    __builtin_amdgcn_s_waitcnt(0);
    unsigned nloc = b.st[0], nx = b.st[1];
    if (nloc == 0u) { xcd_barrier_complete(bar, bx, nloc, nx); b.st[0] = nloc; b.st[1] = nx; }
    const unsigned old = xb_add(&bar[XB_XSUB(bx)], 1u);
    const unsigned gen = old / nloc;
    if (old + 1u == (gen + 1u) * nloc) {
      __builtin_amdgcn_fence(__ATOMIC_RELEASE, "agent");
      asm volatile("s_waitcnt vmcnt(0)" ::: "memory");
      const unsigned og = xb_add(&bar[XB_TOP], 1u);
      const unsigned tg = og / nx;
      if (og + 1u == (tg + 1u) * nx) xb_add(&bar[XB_TOPGEN], 1u);
      else XB_SPIN(xb_ld(&bar[XB_TOPGEN]) == tg, bar);
      __builtin_amdgcn_fence(__ATOMIC_ACQUIRE, "agent");
      xb_add(&bar[XB_XGEN(bx)], 1u);
      asm volatile("s_waitcnt vmcnt(0)" ::: "memory");
    } else {
      XB_SPIN(xb_ld(&bar[XB_XGEN(bx)]) == gen, bar);
      __builtin_amdgcn_fence(__ATOMIC_ACQUIRE, "agent");
      asm volatile("s_waitcnt vmcnt(0)" ::: "memory");
    }
  }
  __syncthreads();
}

struct Params {
  const float *x_prompt, *x_sample, *p_prompt, *p_sample, *norm_g, *final_g, *ple_w, *ple_gate_w, *ab_w_in, *ab_w_out;
  const float *s5_a_re, *s5_a_im, *s5_log_dt, *s5_b_re, *s5_b_im, *s5_c_re, *s5_c_im, *s5_d, *s5_glu_w, *s5_glu_b;
  const float *mla_q_norm, *mla_w_q_up, *mla_kv_norm, *mla_w_kv_up, *hy_w_in, *hy_w_out, *hy_conv_w, *hy_conv_b;
  const float *hy_f_w1, *hy_f_b1, *hy_f_freq1, *hy_f_w2, *hy_f_b2, *hy_f_freq2, *hy_f_w3, *hy_bias;
  float* out; char* ws;
  double rope_inv[32];
};

extern __shared__ __attribute__((aligned(16))) char smem[];

DI bft f2bf(float x) { unsigned u = __float_as_uint(x); u += 0x7fffu + ((u >> 16) & 1u); return (bft)(u >> 16); }
DI float bf2f(bft h) { return __uint_as_float(((unsigned)h) << 16); }
DI unsigned pack2(float a, float b) { return (unsigned)f2bf(a) | ((unsigned)f2bf(b) << 16); }
DI float2 cmul(float2 a, float2 b) { return float2{a.x * b.x - a.y * b.y, a.x * b.y + a.y * b.x}; }
DI float2 cmulc(float2 a, float2 b) { return float2{a.x * b.x + a.y * b.y, a.y * b.x - a.x * b.y}; }
DI float sigm(float x) { return 1.f / (1.f + __expf(-x)); }
DI float siluf(float x) { return x * sigm(x); }
DI float geluf(float x) { float z = 0.7978845608028654f * (x + 0.044715f * x * x * x); float t = 1.f - 2.f / (1.f + __expf(2.f * z)); return 0.5f * x * (1.f + t); }
DI void sincos_d(double ang, float& s, float& c) { double rev = ang * 0.15915494309189535; rev -= rint(rev); float r = (float)rev; s = __builtin_amdgcn_sinf(r); c = __builtin_amdgcn_cosf(r); }
DI float sin_f(float ang) { float rev = ang * 0.15915494309189535f; rev -= rintf(rev); return __builtin_amdgcn_sinf(rev); }
DI float wave_sum(float v) { for (int o = 32; o > 0; o >>= 1) v += __shfl_xor(v, o); return v; }
DI int tok_pos(int tok) { return tok < TP ? (tok & 8191) : (tok & 4095); }
DI int tok_len(int tok) { return tok < TP ? 8192 : 4096; }
__shared__ uint4 xb_words;
DI bool xcd_item(int r, int GS, int ngroups, int& item) {
  const int nb = (int)xb_words.x, nx = (int)xb_words.y, j = (int)xb_words.z, xcd = (int)xb_words.w;
  const int li = r * nb + j, gl = li / GS, gi = gl * nx + xcd;
  if (gi >= ngroups) return false;
  item = gi * GS + (li - gl * GS); return true;
}
DI const float* xrow(const Params& p, int tok) { return tok < TP ? p.x_prompt + (size_t)tok * 1024 : p.x_sample + (size_t)(tok - TP) * 1024; }

struct TrJob { const float* src; int ldsrc, srccol0, k0; bft* dst; int lddst, dstrow0; const float* g; };
DI bool get_trjob(const Params& p, int j, TrJob& o) {
  const int c1 = 944, c2 = c1 + 144, c3 = c2 + 128, c4 = c3 + 256, c5 = c4 + 512, c6 = c5 + 512, c7 = c6 + 128, c8 = c7 + 2048, c9 = c8 + 512;
  int K, N, t; o.g = nullptr;
  if (j < c1) { t = j; K = 1024; N = 3776; o.src = p.ab_w_in; o.dst = (bft*)(p.ws + OFF_W0t); o.g = p.norm_g; }
  else if (j < c2) { t = j - c1; K = 384; N = 1536; o.src = p.mla_w_q_up; o.dst = (bft*)(p.ws + OFF_Wq); o.g = p.mla_q_norm; }
  else if (j < c3) { t = j - c2; K = 256; N = 2048; o.src = p.mla_w_kv_up; o.dst = (bft*)(p.ws + OFF_Wkv); o.g = p.mla_kv_norm; }
  else if (j < c4) { t = j - c3; K = 1024; N = 1024; o.src = p.s5_glu_w; o.dst = (bft*)(p.ws + OFF_Wglu); }
  else if (j < c5) { t = j - c4; K = 2048; N = 1024; o.src = p.ab_w_out; o.dst = (bft*)(p.ws + OFF_Wout0); }
  else if (j < c6) { t = j - c5; int l = t >> 8; t &= 255; K = 1024; N = 1024; o.src = p.ple_gate_w + (size_t)l * 1024 * 1024; o.dst = (bft*)(p.ws + OFF_Wpg + l * SZ_Wsq); }
  else if (j < c7) { t = j - c6; int l = t >> 6; t &= 63; K = 256; N = 1024; o.src = p.ple_w + (size_t)l * 256 * 1024; o.dst = (bft*)(p.ws + OFF_Wpw + l * SZ_Wpw); }
  else if (j < c8) { t = j - c7; K = 1024; N = 8192; o.src = p.hy_w_in; o.dst = (bft*)(p.ws + OFF_W1t); o.g = p.norm_g + 1024; }
  else if (j < c9) { t = j - c8; K = 2048; N = 1024; o.src = p.hy_w_out; o.dst = (bft*)(p.ws + OFF_Wout1); }
  else return false;
  int nt = N / 64; int kt = t / nt, ntile = t % nt;
  o.ldsrc = N; o.srccol0 = ntile * 64; o.k0 = kt * 64; o.lddst = K + 64; o.dstrow0 = ntile * 64;
  if (j >= c7 && j < c8) { int n0 = ntile * 64, part = n0 >> 11, rem = n0 & 2047, ch = rem >> 8, cc0 = rem & 255; o.dstrow0 = ch * 1024 + part * 256 + cc0; }
  return true;
}
constexpr int N_TRJOBS = 944 + 144 + 128 + 256 + 512 + 512 + 128 + 2048 + 512;

DI void phase_prep(const Params& p) {
  int tix_ = threadIdx.x; asm volatile("" : "+v"(tix_));
  const int tid = tix_, lane = tid & 63, wid = tid >> 6;
  float* tile = (float*)smem;
  for (int j = blockIdx.x; j < N_TRJOBS; j += gridDim.x) {
    TrJob jb; get_trjob(p, j, jb);
    { int r = tid >> 6, c = tid & 63;
      for (int i = 0; i < 8; ++i) { int k = i * 8 + r; float v = jb.src[(size_t)(jb.k0 + k) * jb.ldsrc + jb.srccol0 + c]; if (jb.g) v *= jb.g[jb.k0 + k]; tile[k * 65 + c] = v; } }
    __syncthreads();
    { int n = tid >> 3, kq = tid & 7; u32x4 w;
      w[0] = pack2(tile[(kq * 8 + 0) * 65 + n], tile[(kq * 8 + 1) * 65 + n]); w[1] = pack2(tile[(kq * 8 + 2) * 65 + n], tile[(kq * 8 + 3) * 65 + n]);
      w[2] = pack2(tile[(kq * 8 + 4) * 65 + n], tile[(kq * 8 + 5) * 65 + n]); w[3] = pack2(tile[(kq * 8 + 6) * 65 + n], tile[(kq * 8 + 7) * 65 + n]);
      *(u32x4*)(jb.dst + (size_t)(jb.dstrow0 + n) * jb.lddst + jb.k0 + kq * 8) = w; }
    __syncthreads();
  }
  bft* xb = (bft*)(p.ws + OFF_A); float* r0 = (float*)(p.ws + OFF_R0);
  for (int it = blockIdx.x; it < T / 8; it += gridDim.x) {
    int tok = it * 8 + wid; const float* xr = xrow(p, tok); float ss = 0;
    for (int i = 0; i < 4; ++i) { f32x4 v = *(const f32x4*)(xr + i * 256 + lane * 4); ss += v[0] * v[0] + v[1] * v[1] + v[2] * v[2] + v[3] * v[3];
      u32x2 w = {pack2(v[0], v[1]), pack2(v[2], v[3])}; *(u32x2*)(xb + (size_t)tok * LDP + i * 256 + lane * 4) = w; }
    ss = wave_sum(ss); if (lane == 0) r0[tok] = rsqrtf(ss * (1.f / 1024) + EPS);
  }
  const long gsz = (long)gridDim.x * NTHR, gid = (long)blockIdx.x * NTHR + tid;
  { float* z = (float*)(p.ws + OFF_SSQ1); for (long i = gid; i < 2 * T; i += gsz) z[i] = 0.f; }
  { float* rt = (float*)(p.ws + OFF_ROPE); for (long i = gid; i < 8192 * 32; i += gsz) { int pos = (int)(i >> 5), k = (int)(i & 31); float s, c; sincos_d((double)pos * p.rope_inv[k], s, c); rt[pos * 64 + k] = c; rt[pos * 64 + 32 + k] = s; } }
  { float* h2t = (float*)(p.ws + OFF_H2);
    for (int it = blockIdx.x * 8 + wid; it < (8192 + 4096) * 2; it += gridDim.x * 8) {
      int Lsel = it < 16384 ? 0 : 1; int r = Lsel ? it - 16384 : it; int L = Lsel ? 4096 : 8192; int dir = r / L, l = r % L;
      float tl = (float)l / (float)(L - 1); double w = 6.283185307179586 * (double)l / (double)L;
      float zv = 0.f;
      if (lane == 0) zv = tl;
      else if (lane <= 32) { int jj = (lane - 1) & 15; double band = 1e-4 + (double)jj * ((15.0 - 1e-4) / 15.0); float s, c; sincos_d(band * w, s, c); zv = lane <= 16 ? c : -s; }
      const float* w1 = p.hy_f_w1 + (size_t)dir * 33 * 64; float a = p.hy_f_b1[dir * 64 + lane];
      for (int i = 0; i < 33; ++i) a += __shfl(zv, i) * w1[i * 64 + lane];
      float h1 = sin_f(p.hy_f_freq1[dir * 64 + lane] * a);
      const float* w2 = p.hy_f_w2 + (size_t)dir * 64 * 64; float b = p.hy_f_b2[dir * 64 + lane];
      for (int i = 0; i < 64; ++i) b += __shfl(h1, i) * w2[i * 64 + lane];
      float h2 = sin_f(p.hy_f_freq2[dir * 64 + lane] * b);
      size_t base = Lsel ? (size_t)8192 * 2 * 64 : 0; h2t[base + ((size_t)dir * 64 + lane) * L + l] = h2;
    } }
}

struct APlain { const bft* A; int lda; int brow; DI const bft* operator()(int row, int kt, int ch) const { return A + (size_t)(brow + row) * lda + kt * 64 + ch * 8; } };
template <class AF>
DI void gemm_stage(int tid, const AF& af, const bft* Bt, int ldb, int bcol, int kt, char* sA, char* sB) {
#pragma unroll
  for (int i = 0; i < 4; ++i) { int slot = tid + i * 512, row = slot >> 3, ch = (slot & 7) ^ (row & 7);
    __builtin_amdgcn_global_load_lds((const unsigned*)af(row, kt, ch), (unsigned*)(sA + slot * 16), 16, 0, 0); }
#pragma unroll
  for (int i = 0; i < 2; ++i) { int slot = tid + i * 512, row = slot >> 3, ch = (slot & 7) ^ (row & 7);
    __builtin_amdgcn_global_load_lds((const unsigned*)(Bt + (size_t)(bcol + row) * ldb + kt * 64 + ch * 8), (unsigned*)(sB + slot * 16), 16, 0, 0); }
}
DI void gemm_compute(int tid, const char* sA, const char* sB, f32x4 (&acc)[4][4]) {
  const int wid = tid >> 6, lane = tid & 63, wr = wid >> 1, wc = wid & 1, fr = lane & 15, fq = lane >> 4;
#pragma unroll
  for (int kk = 0; kk < 2; ++kk) {
    bf16x8 a[4], b[4];
#pragma unroll
    for (int m = 0; m < 4; ++m) { int row = wr * 64 + m * 16 + fr; a[m] = *(const bf16x8*)(sA + row * 128 + (((kk * 4 + fq) ^ (row & 7)) << 4)); }
#pragma unroll
    for (int n = 0; n < 4; ++n) { int row = wc * 64 + n * 16 + fr; b[n] = *(const bf16x8*)(sB + row * 128 + (((kk * 4 + fq) ^ (row & 7)) << 4)); }
#pragma unroll
    for (int m = 0; m < 4; ++m)
#pragma unroll
      for (int n = 0; n < 4; ++n) acc[m][n] = __builtin_amdgcn_mfma_f32_16x16x32_bf16(a[m], b[n], acc[m][n], 0, 0, 0);
  }
}
template <class AF>
DI void gemm_mainloop_t(int tid, const AF& af, const bft* Bt, int ldb, int bcol, int K, f32x4 (&acc)[4][4]) {
  const int nk = K >> 6;
  gemm_stage(tid, af, Bt, ldb, bcol, 0, smem, smem + 32768);
  if (nk > 1) gemm_stage(tid, af, Bt, ldb, bcol, 1, smem + 49152, smem + 49152 + 32768);
  int cb = 0;
#pragma unroll 1
  for (int kt = 0; kt < nk; ++kt) {
    if (kt + 1 < nk) asm volatile("s_waitcnt vmcnt(6)" ::: "memory"); else asm volatile("s_waitcnt vmcnt(0)" ::: "memory");
    __syncthreads();
    if (kt + 2 < nk) { int nb = cb + 2; if (nb >= 3) nb -= 3; char* nxt = smem + nb * 49152; gemm_stage(tid, af, Bt, ldb, bcol, kt + 2, nxt, nxt + 32768); }
    char* cur = smem + cb * 49152;
    gemm_compute(tid, cur, cur + 32768, acc);
    if (++cb == 3) cb = 0;
  }
  __syncthreads();
}
DI void gemm_mainloop(int tid, const bft* A, int lda, const bft* Bt, int ldb, int brow, int bcol, int K, f32x4 (&acc)[4][4]) {
  APlain af{A, lda, brow}; gemm_mainloop_t(tid, af, Bt, ldb, bcol, K, acc);
}
template <class AF>
DI void g256_stage(int tid, const AF& af, const bft* Bt, int ldb, int bcol, int kt, char* sA, char* sB) {
#pragma unroll
  for (int i = 0; i < 4; ++i) { int slot = tid + i * 512, row = slot >> 3, ch = (slot & 7) ^ (row & 7);
    __builtin_amdgcn_global_load_lds((const unsigned*)af(row, kt, ch), (unsigned*)(sA + slot * 16), 16, 0, 0); }
#pragma unroll
  for (int i = 0; i < 4; ++i) { int slot = tid + i * 512, row = slot >> 3, ch = (slot & 7) ^ (row & 7);
    __builtin_amdgcn_global_load_lds((const unsigned*)(Bt + (size_t)(bcol + row) * ldb + kt * 64 + ch * 8), (unsigned*)(sB + slot * 16), 16, 0, 0); }
}
template <int KK0, int KK1>
DI void g256_compute(int tid, const char* sA, const char* sB, f32x4 (&acc)[8][4]) {
  const int wid = tid >> 6, lane = tid & 63, wr = wid >> 2, wc = wid & 3, fr = lane & 15, fq = lane >> 4;
#pragma unroll
  for (int kk = KK0; kk < KK1; ++kk) {
    bf16x8 b[4], a[4], a2[4];
#pragma unroll
    for (int n = 0; n < 4; ++n) { int row = wc * 64 + n * 16 + fr; b[n] = *(const bf16x8*)(sB + row * 128 + (((kk * 4 + fq) ^ (row & 7)) << 4)); }
#pragma unroll
    for (int m = 0; m < 4; ++m) { int row = wr * 128 + m * 16 + fr; a[m] = *(const bf16x8*)(sA + row * 128 + (((kk * 4 + fq) ^ (row & 7)) << 4)); }
    __builtin_amdgcn_sched_barrier(0);
#pragma unroll
    for (int m = 0; m < 4; ++m) { int row = wr * 128 + (4 + m) * 16 + fr; a2[m] = *(const bf16x8*)(sA + row * 128 + (((kk * 4 + fq) ^ (row & 7)) << 4)); }
    __builtin_amdgcn_s_setprio(1);
#pragma unroll
    for (int m = 0; m < 4; ++m)
#pragma unroll
      for (int n = 0; n < 4; ++n) acc[m][n] = __builtin_amdgcn_mfma_f32_16x16x32_bf16(a[m], b[n], acc[m][n], 0, 0, 0);
    __builtin_amdgcn_sched_barrier(0);
#pragma unroll
    for (int m = 0; m < 4; ++m)
#pragma unroll
      for (int n = 0; n < 4; ++n) acc[4 + m][n] = __builtin_amdgcn_mfma_f32_16x16x32_bf16(a2[m], b[n], acc[4 + m][n], 0, 0, 0);
    __builtin_amdgcn_s_setprio(0);
    __builtin_amdgcn_sched_barrier(0);
  }
}
template <class AF>
DI void g256_mainloop_t(int tid, const AF& af, const bft* Bt, int ldb, int bcol, int K, f32x4 (&acc)[8][4]) {
  const int nk = K >> 6;
  g256_stage(tid, af, Bt, ldb, bcol, 0, smem, smem + 32768);
#pragma unroll 1
  for (int kt = 0; kt < nk; ++kt) {
    asm volatile("s_waitcnt vmcnt(0)" ::: "memory");
    __syncthreads();
    char* cur = smem + (kt & 1) * 65536; char* nxt = smem + ((kt + 1) & 1) * 65536;
    if (tid < 256) {
      if (kt + 1 < nk) g256_stage(tid, af, Bt, ldb, bcol, kt + 1, nxt, nxt + 32768);
      g256_compute<0, 2>(tid, cur, cur + 32768, acc);
    } else {
      g256_compute<0, 1>(tid, cur, cur + 32768, acc);
      if (kt + 1 < nk) g256_stage(tid, af, Bt, ldb, bcol, kt + 1, nxt, nxt + 32768);
      g256_compute<1, 2>(tid, cur, cur + 32768, acc);
    }
  }
  __syncthreads();
}
DI void g256_mainloop(int tid, const bft* A, int lda, const bft* Bt, int ldb, int brow, int bcol, int K, f32x4 (&acc)[8][4]) {
  APlain af{A, lda, brow}; g256_mainloop_t(tid, af, Bt, ldb, bcol, K, acc);
}
#define ACC256_ZERO(acc) for (int m_ = 0; m_ < 8; ++m_) for (int n_ = 0; n_ < 4; ++n_) acc[m_][n_] = f32x4{0.f, 0.f, 0.f, 0.f}
#define ACC_ZERO(acc) for (int m_ = 0; m_ < 4; ++m_) for (int n_ = 0; n_ < 4; ++n_) acc[m_][n_] = f32x4{0.f, 0.f, 0.f, 0.f}
template <int PATCH = 98304> DI void epi_stage(int tid, const f32x4 (&am)[4], float (&v)[16]) {
  const int lane = tid & 63, wid = tid >> 6, fr = lane & 15, fq = lane >> 4;
  float* stg = (float*)(smem + PATCH) + wid * (16 * 68);
  asm volatile("" ::: "memory");
#pragma unroll
  for (int n = 0; n < 4; ++n)
#pragma unroll
    for (int j = 0; j < 4; ++j) stg[(fq * 4 + j) * 68 + n * 16 + fr] = am[n][j];
  asm volatile("s_waitcnt lgkmcnt(0)" ::: "memory");
  const float* rp = stg + (lane >> 2) * 68 + (lane & 3) * 16;
#pragma unroll
  for (int i = 0; i < 4; ++i) { f32x4 t = *(const f32x4*)(rp + i * 4); v[4 * i] = t[0]; v[4 * i + 1] = t[1]; v[4 * i + 2] = t[2]; v[4 * i + 3] = t[3]; }
  asm volatile("" ::: "memory");
}
DI void store16_bf(bft* dst, const float (&v)[16]) {
  u32x4 o0 = {pack2(v[0], v[1]), pack2(v[2], v[3]), pack2(v[4], v[5]), pack2(v[6], v[7])}, o1 = {pack2(v[8], v[9]), pack2(v[10], v[11]), pack2(v[12], v[13]), pack2(v[14], v[15])};
  *(u32x4*)dst = o0; *(u32x4*)(dst + 8) = o1;
}
DI void load16_bf(const bft* src, float (&v)[16]) {
  u32x4 w0 = *(const u32x4*)src, w1 = *(const u32x4*)(src + 8);
#pragma unroll
  for (int i = 0; i < 4; ++i) { v[2 * i] = __uint_as_float(w0[i] << 16); v[2 * i + 1] = __uint_as_float(w0[i] & 0xffff0000u); v[8 + 2 * i] = __uint_as_float(w1[i] << 16); v[8 + 2 * i + 1] = __uint_as_float(w1[i] & 0xffff0000u); }
}
DI void load16_f(const float* src, float (&v)[16]) {
#pragma unroll
  for (int i = 0; i < 4; ++i) { f32x4 t = *(const f32x4*)(src + 4 * i); v[4 * i] = t[0]; v[4 * i + 1] = t[1]; v[4 * i + 2] = t[2]; v[4 * i + 3] = t[3]; }
}
DI void store16_f(float* dst, const float (&v)[16]) {
#pragma unroll
  for (int i = 0; i < 4; ++i) { f32x4 t = {v[4 * i], v[4 * i + 1], v[4 * i + 2], v[4 * i + 3]}; *(f32x4*)(dst + 4 * i) = t; }
}
#define EPI_BEGIN const int wid = tid >> 6, lane = tid & 63, wr = wid >> 1, wc = wid & 1; \
  _Pragma("unroll") for (int m = 0; m < 4; ++m) { float v[16]; epi_stage(tid, acc[m], v); const int row = brow + wr * 64 + m * 16 + (lane >> 2), col = bcol + wc * 64 + (lane & 3) * 16; (void)row; (void)col;
#define EPI_END }
#define EPI256_BEGIN const int wid = tid >> 6, lane = tid & 63, wr = wid >> 2, wc = wid & 3; \
  _Pragma("unroll") for (int m = 0; m < 8; ++m) { float v[16]; epi_stage<65536>(tid, acc[m], v); const int row = brow + wr * 128 + m * 16 + (lane >> 2), col = bcol + wc * 64 + (lane & 3) * 16; (void)row; (void)col;

DI void phase_inproj0(const Params& p) {
  int tix_ = threadIdx.x; asm volatile("" : "+v"(tix_));
  const bft* A = (const bft*)(p.ws + OFF_A); const bft* Bt = (const bft*)(p.ws + OFF_W0t); const float* r0 = (const float*)(p.ws + OFF_R0);
  bft* u = (bft*)(p.ws + OFF_U); bft* lat = (bft*)(p.ws + OFF_LAT); bft* G0 = (bft*)(p.ws + OFF_G0);
  const int NT = 15, MT = T / 256;
  for (int r_ = 0, it; xcd_item(r_, NT, MT, it); ++r_) {
    int brow = (it / NT) * 256, bcol = (it % NT) * 256;
    int tid = tix_; asm volatile("" : "+v"(tid));
    f32x4 acc[8][4]; ACC256_ZERO(acc);
    g256_mainloop(tid, A, LDP, Bt, LDW1, brow, bcol, 1024, acc);
    EPI256_BEGIN
      float rs = r0[row];
#pragma unroll
      for (int i = 0; i < 16; ++i) v[i] *= rs;
      if (col < 1024) store16_bf(u + (size_t)row * 1024 + col, v);
      else if (col < 1728) store16_bf(lat + (size_t)row * 704 + col - 1024, v);
      else if (col < 3776) {
#pragma unroll
        for (int i = 0; i < 16; ++i) v[i] = siluf(v[i]);
        store16_bf(G0 + (size_t)row * 2048 + col - 1728, v); }
    EPI_END
  }
}

DI void phase_mlaprep(const Params& p) {
  int tix_ = threadIdx.x; asm volatile("" : "+v"(tix_));
  const int lane = tix_ & 63, wid = tix_ >> 6;
  bft* lat = (bft*)(p.ws + OFF_LAT); const float* rt = (const float*)(p.ws + OFF_ROPE);
  for (int it = blockIdx.x; it < T / 8; it += gridDim.x) {
    int tok = it * 8 + wid; bft* r = lat + (size_t)tok * 704;
    float q[6], kv[4], ss = 0, ss2 = 0;
    for (int i = 0; i < 6; ++i) { q[i] = bf2f(r[lane + 64 * i]); ss += q[i] * q[i]; }
    for (int i = 0; i < 4; ++i) { kv[i] = bf2f(r[384 + lane + 64 * i]); ss2 += kv[i] * kv[i]; }
    float kr = bf2f(r[640 + lane]);
    ss = wave_sum(ss); ss2 = wave_sum(ss2);
    float rq = rsqrtf(ss * (1.f / 384) + EPS), rkv = rsqrtf(ss2 * (1.f / 256) + EPS);
    for (int i = 0; i < 6; ++i) r[lane + 64 * i] = f2bf(q[i] * rq);
    for (int i = 0; i < 4; ++i) r[384 + lane + 64 * i] = f2bf(kv[i] * rkv);
    int pos = tok_pos(tok); float c = rt[pos * 64 + (lane & 31)], s = rt[pos * 64 + 32 + (lane & 31)];
    float xo = __shfl_xor(kr, 32);
    float o = lane < 32 ? kr * c - xo * s : xo * s + kr * c;
    r[640 + lane] = f2bf(o);
  }
}

constexpr int S5Q = 32, S5NC = T / S5Q;
constexpr size_t S5_OFF_S = 0, S5_OFF_X = (size_t)64 * S5NC * 256 * 4, S5_OFF_TM = S5_OFF_X + (size_t)64 * S5NC * 256 * 2;
DI void s5_lam(const Params& p, int dir, int g, int m, float tau, float& pr, float& pi) {
  int idx = (dir * 64 + g) * 64 + m; float are = p.s5_a_re[idx], aim = p.s5_a_im[idx], dt = __expf(p.s5_log_dt[dir * 64 + g]);
  float mag = __expf(are * dt * tau), s, c; sincos_d((double)aim * (double)dt * (double)tau, s, c); pr = mag * c; pi = mag * s;
}
DI void phase_s5gen(const Params& p) {
  int tix_ = threadIdx.x; asm volatile("" : "+v"(tix_));
  const int tid = tix_;
  float2* pw = (float2*)smem;
  float2* Bb = (float2*)(smem + 33792);
  float2* Cc = (float2*)(smem + 33792 + 16384);
  float* Kt = (float*)(smem + 33792 + 32768);
  bft* Tm = (bft*)((char*)p.out + S5_OFF_TM); bft* W1 = (bft*)(p.ws + OFF_A);
  for (int it = blockIdx.x; it < 256; it += gridDim.x) {
    const int g = it >> 2, q4 = it & 3;
    if (tid < 128) { int d = tid >> 6, m = tid & 63; int idx = (d * 64 + g) * 64 + m;
      float are = p.s5_a_re[idx], aim = p.s5_a_im[idx];
      for (int tau = 0; tau <= 32; ++tau) { float pr, pi; s5_lam(p, d, g, m, (float)tau, pr, pi); pw[(d * 33 + tau) * 64 + m] = float2{pr, pi}; }
      float abr, abi; s5_lam(p, d, g, m, 1.f, abr, abi);
      float den = are * are + aim * aim, cr = ((abr - 1.f) * are + abi * aim) / den, ci = (abi * are - (abr - 1.f) * aim) / den;
      for (int c = 0; c < 16; ++c) { float br = p.s5_b_re[(size_t)idx * 16 + c], bi = p.s5_b_im[(size_t)idx * 16 + c]; Bb[(d * 64 + m) * 16 + c] = float2{cr * br - ci * bi, cr * bi + ci * br};
        Cc[(d * 16 + c) * 64 + m] = float2{p.s5_c_re[((size_t)(d * 64 + g) * 16 + c) * 64 + m], p.s5_c_im[((size_t)(d * 64 + g) * 16 + c) * 64 + m]}; } }
    __syncthreads();
    for (int e = tid; e < 1024; e += NTHR) {
      const int d = e >> 9, tau = (e >> 4) & 31, cb = ((e >> 2) & 3) * 4, c2b = (e & 3) * 4; float acc[4][4];
#pragma unroll
      for (int i = 0; i < 4; ++i)
#pragma unroll
        for (int j = 0; j < 4; ++j) acc[i][j] = 0.f;
      for (int m = 0; m < 64; ++m) { const float2 pwv = pw[(d * 33 + tau) * 64 + m]; float2 P[4], B[4];
#pragma unroll
        for (int i = 0; i < 4; ++i) { P[i] = cmul(Cc[(d * 16 + cb + i) * 64 + m], pwv); B[i] = Bb[(d * 64 + m) * 16 + c2b + i]; }
#pragma unroll
        for (int i = 0; i < 4; ++i)
#pragma unroll
          for (int j = 0; j < 4; ++j) acc[i][j] += P[i].x * B[j].x - P[i].y * B[j].y; }
#pragma unroll
      for (int i = 0; i < 4; ++i)
#pragma unroll
        for (int j = 0; j < 4; ++j) Kt[((d * 32 + tau) * 16 + cb + i) * 16 + c2b + j] = acc[i][j]; }
    __syncthreads();
    for (int e = tid; e < 128 * 96; e += NTHR) { int n = q4 * 128 + e / 96, k8 = e % 96; int to = n >> 4, c = n & 15; float v[8];
      if (k8 < 64) { int ti = k8 >> 1, c0 = (k8 & 1) * 8;
#pragma unroll
        for (int j = 0; j < 8; ++j) { int c2 = c0 + j; float x;
          if (to > ti) x = Kt[((0 * 32 + (to - ti)) * 16 + c) * 16 + c2]; else if (to < ti) x = Kt[((1 * 32 + (ti - to)) * 16 + c) * 16 + c2];
          else { x = Kt[(c) * 16 + c2] + Kt[((32) * 16 + c) * 16 + c2]; if (c == c2) x += p.s5_d[g * 16 + c]; }
          v[j] = x; } }
      else {
#pragma unroll
        for (int j = 0; j < 8; ++j) { int kk = k8 * 8 - 512 + j; int d = kk >> 7, ri = (kk >> 6) & 1, m = kk & 63; int pwr = d == 0 ? to + 1 : 32 - to;
          float2 P = cmul(Cc[(d * 16 + c) * 64 + m], pw[(d * 33 + pwr) * 64 + m]); v[j] = ri == 0 ? P.x : -P.y; } }
      u32x4 w = {pack2(v[0], v[1]), pack2(v[2], v[3]), pack2(v[4], v[5]), pack2(v[6], v[7])};
      *(u32x4*)(Tm + ((size_t)g * 512 + n) * 768 + k8 * 8) = w; }
    for (int e = tid; e < 64 * 64; e += NTHR) { int n = q4 * 64 + (e >> 6), k8 = e & 63; int d = n >> 7, ri = (n >> 6) & 1, m = n & 63; float v[8];
#pragma unroll
      for (int j = 0; j < 8; ++j) { int k = k8 * 8 + j, tau = k >> 4, c2 = k & 15; int pwr = d == 0 ? 31 - tau : tau;
        float2 V = cmul(pw[(d * 33 + pwr) * 64 + m], Bb[(d * 64 + m) * 16 + c2]); v[j] = ri == 0 ? V.x : V.y; }
      u32x4 w = {pack2(v[0], v[1]), pack2(v[2], v[3]), pack2(v[4], v[5]), pack2(v[6], v[7])};
      *(u32x4*)(W1 + ((size_t)g * 256 + n) * 512 + k8 * 8) = w; }
    __syncthreads();
  }
}
struct AS5 { const bft* u; const bft* X; int g, mrow0; bool withX;
  DI const bft* operator()(int row, int kt, int ch) const {
    if (kt < 8) return u + ((size_t)((mrow0 + row) * 32 + kt * 4 + (ch >> 1)) * 1024 + g * 16 + (ch & 1) * 8);
    return X + ((size_t)(g * S5NC + mrow0 + row) * 256 + (kt - 8) * 64 + ch * 8); } };
DI void phase_s5step1(const Params& p) {
  int tix_ = threadIdx.x; asm volatile("" : "+v"(tix_));
  const bft* u = (const bft*)(p.ws + OFF_U); const bft* W1 = (const bft*)(p.ws + OFF_A); float* S = (float*)((char*)p.out + S5_OFF_S);
  for (int r_ = 0, it; xcd_item(r_, 6, 64, it); ++r_) {
    int g = it / 6, mt = it % 6; const int brow = mt * 256, bcol = 0;
    int tid = tix_; asm volatile("" : "+v"(tid));
    f32x4 acc[8][4]; ACC256_ZERO(acc);
    AS5 af{u, nullptr, g, brow, false};
    g256_mainloop_t(tid, af, W1 + (size_t)g * 256 * 512, 512, bcol, 512, acc);
    EPI256_BEGIN
      store16_f(S + ((size_t)g * S5NC + row) * 256 + col, v);
    EPI_END
  }
}
DI void phase_s5scan(const Params& p) {
  int tix_ = threadIdx.x; asm volatile("" : "+v"(tix_));
  const int lane = tix_ & 63, wid = tix_ >> 6;
  const float* S = (const float*)((char*)p.out + S5_OFF_S); bft* X = (bft*)((char*)p.out + S5_OFF_X);
  for (int wi = blockIdx.x * 8 + wid; wi < 1280; wi += gridDim.x * 8) {
    int dir = wi & 1, g = (wi >> 1) & 63, s = wi >> 7;
    int L = s < 2 ? 8192 : 4096; int tok0 = s < 2 ? s * 8192 : TP + (s - 2) * 4096; int nch = L / S5Q, kc0 = tok0 / S5Q;
    float aqr, aqi; s5_lam(p, dir, g, lane, (float)S5Q, aqr, aqi);
    float xr = 0.f, xi = 0.f;
    for (int kb = 0; kb < nch; kb += 8) {
      float sr[8], si[8];
#pragma unroll
      for (int i = 0; i < 8; ++i) { int k = dir ? nch - 1 - (kb + i) : kb + i; const float* sp = S + ((size_t)g * S5NC + kc0 + k) * 256 + dir * 128 + lane; sr[i] = sp[0]; si[i] = sp[64]; }
#pragma unroll
      for (int i = 0; i < 8; ++i) { int k = dir ? nch - 1 - (kb + i) : kb + i; bft* xp = X + ((size_t)g * S5NC + kc0 + k) * 256 + dir * 128 + lane;
        xp[0] = f2bf(xr); xp[64] = f2bf(xi);
        float nr = aqr * xr - aqi * xi + sr[i], ni = aqr * xi + aqi * xr + si[i]; xr = nr; xi = ni; }
    }
  }
}
DI void phase_s5step3(const Params& p) {
  int tix_ = threadIdx.x; asm volatile("" : "+v"(tix_));
  const bft* u = (const bft*)(p.ws + OFF_U); const bft* X = (const bft*)((char*)p.out + S5_OFF_X); const bft* Tm = (const bft*)((char*)p.out + S5_OFF_TM);
  bft* ys = (bft*)(p.ws + OFF_A);
  for (int r_ = 0, it; xcd_item(r_, 12, 64, it); ++r_) {
    int g = it / 12, r = it % 12, mt = r >> 1, nt = r & 1; const int brow = mt * 256, bcol = nt * 256;
    int tid = tix_; asm volatile("" : "+v"(tid));
    f32x4 acc[8][4]; ACC256_ZERO(acc);
    AS5 af{u, X, g, brow, true};
    g256_mainloop_t(tid, af, Tm + (size_t)g * 512 * 768, 768, bcol, 768, acc);
    EPI256_BEGIN
#pragma unroll
      for (int i = 0; i < 16; ++i) v[i] = geluf(v[i]);
      store16_bf(ys + ((size_t)row * 32 + (col >> 4)) * LDP + g * 16, v);
    EPI_END
  }
}

DI void phase_upproj(const Params& p, int sg) {
  int tix_ = threadIdx.x; asm volatile("" : "+v"(tix_));
  const bft* lat = (const bft*)(p.ws + OFF_LAT) + (size_t)sg * 16384 * 704;
  bft* Q = (bft*)p.out; bft* Kb = Q + (size_t)16384 * 1536; bft* Vb = Kb + (size_t)16384 * 1536;
  const float* rt = (const float*)(p.ws + OFF_ROPE);
  const int MT = 64, NQ = 6, NKV = 8;
  for (int r_ = 0, it; xcd_item(r_, NQ + NKV, MT, it); ++r_) {
    const int mt_ = it / (NQ + NKV), nr_ = it % (NQ + NKV);
    int tid = tix_; asm volatile("" : "+v"(tid));
    f32x4 acc[8][4]; ACC256_ZERO(acc);
    if (nr_ < NQ) {
      int brow = mt_ * 256, bcol = nr_ * 256;
      g256_mainloop(tid, lat, 704, (const bft*)(p.ws + OFF_Wq), LDWQ, brow, bcol, 384, acc);
      EPI256_BEGIN
        const int cw = bcol + wc * 64; const bool is_rope = (cw % 192) == 128;
        if (is_rope) { int pos = tok_pos(sg * 16384 + row); const int cg = lane & 3; const float* rp = rt + pos * 64 + (cg & 1) * 16;
#pragma unroll
          for (int i = 0; i < 16; ++i) { float c = rp[i], s = rp[32 + i]; float xo = __shfl_xor(v[i], 2); v[i] = cg < 2 ? v[i] * c - xo * s : xo * s + v[i] * c; } }
        store16_bf(Q + (size_t)row * 1536 + col, v);
      EPI_END
    } else {
      int brow = mt_ * 256, nt = nr_ - NQ, bcol = nt * 256;
      g256_mainloop(tid, lat + 384, 704, (const bft*)(p.ws + OFF_Wkv), LDWS, brow, bcol, 256, acc);
      const int h = nt;
      EPI256_BEGIN
        const int d = col - bcol;
        if (d >= 128) store16_bf(Vb + (size_t)row * 1024 + h * 128 + d - 128, v); else store16_bf(Kb + (size_t)row * 1536 + h * 192 + d, v);
      EPI_END
      { for (int i = tix_; i < 256 * 8; i += 512) { int r = i >> 3, c8 = i & 7;
          *(u32x4*)(Kb + (size_t)(brow + r) * 1536 + h * 192 + 128 + c8 * 8) = *(const u32x4*)(lat + (size_t)(brow + r) * 704 + 640 + c8 * 8); } }
    }
  }
}

constexpr int KVBLK = 64;
constexpr float ATT_SCALE = 0.07216878364870323f;
constexpr float ATT_THR = 8.f;
constexpr int SHM_V = KVBLK * 128 * 2, SHM_K = KVBLK * 400;
#define KSWZ(row, colB) ((row) * 400 + (colB))
#define SBAR() __builtin_amdgcn_sched_barrier(0)
DI int crow(int r, int hi) { return (r & 3) + 8 * (r >> 2) + 4 * hi; }
DI unsigned cvtpk(float lo, float hi) { unsigned r; asm volatile("v_cvt_pk_bf16_f32 %0, %1, %2" : "=v"(r) : "v"(lo), "v"(hi)); return r; }
DI void partialSM(f32x16& p0, f32x16& p1, float& m_reg, float& mn, float& alpha) {
  constexpr float C = ATT_SCALE * 1.4426950408889634f;
  float pmax = p0[0];
#pragma unroll
  for (int r = 1; r < 16; ++r) pmax = fmaxf(pmax, p0[r]);
#pragma unroll
  for (int r = 0; r < 16; ++r) pmax = fmaxf(pmax, p1[r]);
  { auto rr = __builtin_amdgcn_permlane32_swap(__float_as_uint(pmax), __float_as_uint(pmax), false, false);
    pmax = fmaxf(__uint_as_float(rr[0]), __uint_as_float(rr[1])); }
  if (__builtin_expect(__all(pmax - m_reg <= ATT_THR / ATT_SCALE), 1)) { mn = m_reg; alpha = 1.f; }
  else { mn = fmaxf(m_reg, pmax); alpha = __builtin_amdgcn_exp2f((m_reg - mn) * C); m_reg = mn; }
  float mnC = -mn * C;
#pragma unroll
  for (int r = 0; r < 16; ++r) p0[r] = fmaf(p0[r], C, mnC);
#pragma unroll
  for (int r = 0; r < 16; ++r) p1[r] = fmaf(p1[r], C, mnC);
#pragma unroll
  for (int r = 0; r < 16; ++r) p0[r] = __builtin_amdgcn_exp2f(p0[r]);
}
DI void finishSM(f32x16& p0, f32x16& p1, float alpha, float& l_reg, bf16x8& pa0, bf16x8& pa1, bf16x8& pa2, bf16x8& pa3) {
#pragma unroll
  for (int r = 0; r < 16; ++r) p1[r] = __builtin_amdgcn_exp2f(p1[r]);
  float ps = 0;
#pragma unroll
  for (int r = 0; r < 16; ++r) ps += p0[r];
#pragma unroll
  for (int r = 0; r < 16; ++r) ps += p1[r];
  { auto rr = __builtin_amdgcn_permlane32_swap(__float_as_uint(ps), __float_as_uint(ps), false, false);
    ps = __uint_as_float(rr[0]) + __uint_as_float(rr[1]); }
  l_reg = l_reg * alpha + ps;
#define PK4(P, BASE, OUT) do { unsigned a0 = cvtpk(P[BASE + 0], P[BASE + 1]), a1 = cvtpk(P[BASE + 2], P[BASE + 3]);   \
    unsigned b0 = cvtpk(P[BASE + 4], P[BASE + 5]), b1 = cvtpk(P[BASE + 6], P[BASE + 7]);                              \
    auto r0 = __builtin_amdgcn_permlane32_swap(a0, b0, false, false); auto r1 = __builtin_amdgcn_permlane32_swap(a1, b1, false, false); \
    u32x4 w = {r0[0], r1[0], r0[1], r1[1]}; OUT = *reinterpret_cast<bf16x8*>(&w); } while (0)
  PK4(p0, 0, pa0); PK4(p0, 8, pa1); PK4(p1, 0, pa2); PK4(p1, 8, pa3);
#undef PK4
}
DI void qkt(f32x16& p0, f32x16& p1, const char* Ks, const bf16x8* qr, int r32, int hi) {
  p0 = f32x16{}; p1 = f32x16{};
#pragma unroll
  for (int d0 = 0; d0 < 12; ++d0) { int cb = (d0 * 16 + hi * 8) * 2;
    bf16x8 b0 = *reinterpret_cast<const bf16x8*>(Ks + KSWZ(r32, cb));
    bf16x8 b1 = *reinterpret_cast<const bf16x8*>(Ks + KSWZ(32 + r32, cb));
    p0 = __builtin_amdgcn_mfma_f32_32x32x16_bf16(b0, qr[d0], p0, 0, 0, 0);
    p1 = __builtin_amdgcn_mfma_f32_32x32x16_bf16(b1, qr[d0], p1, 0, 0, 0); }
}
DI int v_st(int k, int c) { const int kk = (k & ~0xC) | ((k & 4) << 1) | ((k & 8) >> 1); return ((kk >> 3) * 4 + (c >> 5)) * 512 + ((kk & 7) * 32 + (c & 31)) * 2; }
DI int v_rd_base(int lane) { return ((lane & 3) << 3) | (((lane >> 2) & 3) << 6) | (((lane >> 4) & 1) << 5) | (((lane >> 5) & 1) << 8); }
constexpr int v_rd_off(int d0, int ks, int half) { return d0 * 512 + ks * 4096 + half * 2048; }
template <int OFF> DI s16x4 tr_read(int vb) { s16x4 r; asm volatile("ds_read_b64_tr_b16 %0, %1 offset:%2" : "=&v"(r) : "v"(vb), "i"(OFF) : "memory"); return r; }
template <int D0> DI void pv_one(f32x16& od, int vb, bf16x8 pa0, bf16x8 pa1, bf16x8 pa2, bf16x8 pa3) {
  const s16x4 l0 = tr_read<v_rd_off(D0, 0, 0)>(vb), h0 = tr_read<v_rd_off(D0, 0, 1)>(vb), l1 = tr_read<v_rd_off(D0, 1, 0)>(vb), h1 = tr_read<v_rd_off(D0, 1, 1)>(vb);
  const s16x4 l2 = tr_read<v_rd_off(D0, 2, 0)>(vb), h2 = tr_read<v_rd_off(D0, 2, 1)>(vb), l3 = tr_read<v_rd_off(D0, 3, 0)>(vb), h3 = tr_read<v_rd_off(D0, 3, 1)>(vb);
  asm volatile("s_waitcnt lgkmcnt(0)" ::: "memory"); SBAR();
#define PK(L, H) (bf16x8){L[0], L[1], L[2], L[3], H[0], H[1], H[2], H[3]}
  od = __builtin_amdgcn_mfma_f32_32x32x16_bf16(pa0, PK(l0, h0), od, 0, 0, 0);
  od = __builtin_amdgcn_mfma_f32_32x32x16_bf16(pa1, PK(l1, h1), od, 0, 0, 0);
  od = __builtin_amdgcn_mfma_f32_32x32x16_bf16(pa2, PK(l2, h2), od, 0, 0, 0);
  od = __builtin_amdgcn_mfma_f32_32x32x16_bf16(pa3, PK(l3, h3), od, 0, 0, 0);
#undef PK
}
DI void pv_d0(f32x16* o, int vb, bf16x8 pa0, bf16x8 pa1, bf16x8 pa2, bf16x8 pa3) {
  pv_one<0>(o[0], vb, pa0, pa1, pa2, pa3); pv_one<1>(o[1], vb, pa0, pa1, pa2, pa3); pv_one<2>(o[2], vb, pa0, pa1, pa2, pa3); pv_one<3>(o[3], vb, pa0, pa1, pa2, pa3);
}
DI void attn_body(const bft* __restrict__ Qb, const bft* __restrict__ Kh, const bft* __restrict__ Vh, bft* __restrict__ Gb, int seq) {
  int tid = threadIdx.x; asm volatile("" : "+v"(tid));
  const int wid = tid >> 6, lane = tid & 63, r32 = lane & 31, hi = lane >> 5;
  char* V_lds = smem; char* K_lds = smem + 2 * SHM_V;
  float* wsl = (float*)(smem + 2 * SHM_V + 2 * SHM_K) + wid * 64; float* li_l = wsl; float* al_l = wsl + 32;
  float m_reg = -1e30f, l_reg = 0; f32x16 o[4] = {}; bf16x8 qr[12];
  const bft* Qw = Qb + (size_t)(wid * 32 + r32) * 1536 + hi * 8;
#pragma unroll
  for (int d0 = 0; d0 < 12; ++d0) qr[d0] = *(const bf16x8*)(Qw + d0 * 16);
  const int sr = tid >> 4, sc = (tid & 15) * 8, vst0 = v_st(sr, sc), vst1 = v_st(32 + sr, sc);
  const int kr0 = tid / 24, kc0 = (tid % 24) * 8, kr1 = (tid + 512) / 24, kc1 = ((tid + 512) % 24) * 8, kr2 = (tid + 1024) / 24, kc2 = ((tid + 1024) % 24) * 8;
  const int vb0 = (int)(uintptr_t)V_lds + v_rd_base(lane);
  bf16x8 vs0, vs1, ks0, ks1, ks2;
#define SLOAD(k0) do { vs0 = *(const bf16x8*)(&Vh[(size_t)((k0) + sr) * 1024 + sc]); vs1 = *(const bf16x8*)(&Vh[(size_t)((k0) + 32 + sr) * 1024 + sc]); \
    ks0 = *(const bf16x8*)(&Kh[(size_t)((k0) + kr0) * 1536 + kc0]); ks1 = *(const bf16x8*)(&Kh[(size_t)((k0) + kr1) * 1536 + kc1]); ks2 = *(const bf16x8*)(&Kh[(size_t)((k0) + kr2) * 1536 + kc2]); } while (0)
#define SWRITE(b) do { *(bf16x8*)(V_lds + (b) * SHM_V + vst0) = vs0; *(bf16x8*)(V_lds + (b) * SHM_V + vst1) = vs1; \
    *(bf16x8*)(K_lds + (b) * SHM_K + KSWZ(kr0, kc0 * 2)) = ks0; *(bf16x8*)(K_lds + (b) * SHM_K + KSWZ(kr1, kc1 * 2)) = ks1; *(bf16x8*)(K_lds + (b) * SHM_K + KSWZ(kr2, kc2 * 2)) = ks2; } while (0)
#define SWAIT() asm volatile("s_waitcnt vmcnt(0)" ::: "memory")
#define RESC(a) do { if (__any((a) < 1.f)) { if (hi == 0) al_l[r32] = (a); asm volatile("s_waitcnt lgkmcnt(0)" ::: "memory"); \
    for (int d = 0; d < 4; ++d) for (int r = 0; r < 16; ++r) o[d][r] *= al_l[crow(r, hi)]; } } while (0)
  f32x16 pA0, pA1; float mnA, alA; bf16x8 pa0, pa1, pa2, pa3; const int NT = seq / KVBLK;
  SLOAD(0); SWAIT(); SWRITE(0); __syncthreads();
  for (int j = 0; j < NT; ++j) {
    const int b = j & 1;
    if (j + 1 < NT) SLOAD((j + 1) * KVBLK);
    SBAR(); qkt(pA0, pA1, K_lds + b * SHM_K, qr, r32, hi);
    partialSM(pA0, pA1, m_reg, mnA, alA);
    RESC(alA);
    finishSM(pA0, pA1, alA, l_reg, pa0, pa1, pa2, pa3); SBAR();
    pv_d0(o, vb0 + b * SHM_V, pa0, pa1, pa2, pa3);
    if (j + 1 < NT) { SWAIT(); SWRITE(b ^ 1); }
    __syncthreads();
  }
  if (hi == 0) li_l[r32] = l_reg; asm volatile("s_waitcnt lgkmcnt(0)" ::: "memory");
  float rli[16];
#pragma unroll
  for (int r = 0; r < 16; ++r) rli[r] = __builtin_amdgcn_rcpf(li_l[crow(r, hi)]);
  bft* Gw = Gb + (size_t)(wid * 32) * 2048;
#pragma unroll
  for (int r = 0; r < 16; ++r) { int orow = crow(r, hi);
#pragma unroll
    for (int d0 = 0; d0 < 4; ++d0) { bft* gp = Gw + (size_t)orow * 2048 + d0 * 32 + r32; *gp = f2bf(o[d0][r] * rli[r] * bf2f(*gp)); } }
  __syncthreads();
#undef SLOAD
#undef SWRITE
#undef SWAIT
#undef RESC
}
DI void phase_attn(const Params& p, int sg) {
  int tix_ = threadIdx.x; asm volatile("" : "+v"(tix_));
  const bft* Q = (const bft*)p.out; const bft* Kb = Q + (size_t)16384 * 1536; const bft* Vb = Kb + (size_t)16384 * 1536;
  bft* G0 = (bft*)(p.ws + OFF_G0) + (size_t)sg * 16384 * 2048;
  const int L = sg == 0 ? 8192 : 4096; const int nqb = L / 256;
  for (int r_ = 0, it; xcd_item(r_, nqb, 512 / nqb, it); ++r_) {
    int qb = it % nqb, rest = it / nqb, h = rest & 7, sl = rest >> 3;
    size_t t0 = (size_t)sl * L;
    attn_body(Q + (t0 + qb * 256) * 1536 + h * 192, Kb + t0 * 1536 + h * 192, Vb + t0 * 1024 + h * 128, G0 + (t0 + qb * 256) * 2048 + 1024 + h * 128, L);
  }
}

DI void convert_p(const Params& p, int layer) {
  int tix_ = threadIdx.x; asm volatile("" : "+v"(tix_));
  bft* pb = (bft*)(p.ws + OFF_LAT);
  const long gsz = (long)gridDim.x * NTHR, gid = (long)blockIdx.x * NTHR + tix_;
  const float* pp = p.p_prompt + (size_t)layer * TP * 256; const float* ps = p.p_sample + (size_t)layer * (T - TP) * 256;
  for (long i = gid; i < (long)T * 256 / 4; i += gsz) { long e = i * 4; f32x4 v = e < (long)TP * 256 ? *(const f32x4*)(pp + e) : *(const f32x4*)(ps + (e - (long)TP * 256));
    u32x2 w = {pack2(v[0], v[1]), pack2(v[2], v[3])}; *(u32x2*)(pb + e) = w; }
}
DI void phase_glu(const Params& p) {
  int tix_ = threadIdx.x; asm volatile("" : "+v"(tix_));
  const bft* ys = (const bft*)(p.ws + OFF_A); bft* G0 = (bft*)(p.ws + OFF_G0);
  for (int r_ = 0, it; xcd_item(r_, 4, T / 256, it); ++r_) {
    int brow = (it >> 2) * 256, bcol = (it & 3) * 256;
    int tid = tix_; asm volatile("" : "+v"(tid));
    f32x4 acc[8][4]; ACC256_ZERO(acc);
    g256_mainloop(tid, ys, LDP, (const bft*)(p.ws + OFF_Wglu), LDW1, brow, bcol, 1024, acc);
    EPI256_BEGIN
      float y[16], g[16], b[16]; load16_bf(ys + (size_t)row * LDP + col, y); bft* gp = G0 + (size_t)row * 2048 + col; load16_bf(gp, g); load16_f(p.s5_glu_b + col, b);
#pragma unroll
      for (int i = 0; i < 16; ++i) v[i] = y[i] * sigm(v[i] + b[i]) * g[i];
      store16_bf(gp, v);
    EPI_END
  }
  convert_p(p, 0);
}

DI void phase_outproj0(const Params& p) {
  int tix_ = threadIdx.x; asm volatile("" : "+v"(tix_));
  const bft* G0 = (const bft*)(p.ws + OFF_G0); bft* hb = (bft*)(p.ws + OFF_U);
  for (int r_ = 0, it; xcd_item(r_, 4, T / 256, it); ++r_) {
    int brow = (it >> 2) * 256, bcol = (it & 3) * 256;
    int tid = tix_; asm volatile("" : "+v"(tid));
    f32x4 acc[8][4]; ACC256_ZERO(acc);
    g256_mainloop(tid, G0, 2048, (const bft*)(p.ws + OFF_Wout0), LDW2, brow, bcol, 2048, acc);
    EPI256_BEGIN
      float x[16]; load16_f(xrow(p, row) + col, x);
#pragma unroll
      for (int i = 0; i < 16; ++i) v[i] += x[i];
      store16_f(p.out + (size_t)row * 1024 + col, v); store16_bf(hb + (size_t)row * 1024 + col, v);
    EPI_END
  }
}

DI void phase_ple(const Params& p, int layer, const bft* hbin, bft* hbout, int ldo, float* ssq) {
  int tix_ = threadIdx.x; asm volatile("" : "+v"(tix_));
  const bft* pb = (const bft*)(p.ws + OFF_LAT);
  for (int r_ = 0, it; xcd_item(r_, 8, T / 256, it); ++r_) {
    int brow = (it >> 3) * 256, bcol = (it & 7) * 128;
    int tid = tix_; asm volatile("" : "+v"(tid));
    f32x4 acc[4][4], acc2[4][4]; ACC_ZERO(acc); ACC_ZERO(acc2);
    gemm_mainloop(tid, hbin, 1024, (const bft*)(p.ws + OFF_Wpg + layer * SZ_Wsq), LDW1, brow, bcol, 1024, acc);
    gemm_mainloop(tid, pb, 256, (const bft*)(p.ws + OFF_Wpw + layer * SZ_Wpw), LDWS, brow, bcol, 256, acc2);
    EPI_BEGIN
      float v2[16]; epi_stage(tid, acc2[m], v2); float h[16]; float* hp = p.out + (size_t)row * 1024 + col; load16_f(hp, h); float ss = 0.f;
#pragma unroll
      for (int i = 0; i < 16; ++i) { h[i] += sigm(v[i]) * v2[i]; ss += h[i] * h[i]; }
      store16_f(hp, h); if (hbout) store16_bf(hbout + (size_t)row * ldo + col, h);
      ss += __shfl_xor(ss, 1); ss += __shfl_xor(ss, 2);
      if ((lane & 3) == 0) atomicAdd(ssq + row, ss);
    EPI_END
  }
}

DI void phase_inproj1(const Params& p, int ch) {
  int tix_ = threadIdx.x; asm volatile("" : "+v"(tix_));
  const bft* hb = (const bft*)(p.ws + OFF_A); bft* Z = (bft*)(p.ws + OFF_U); const float* ssq1 = (const float*)(p.ws + OFF_SSQ1);
  const bft* Bt = (const bft*)(p.ws + OFF_W1t) + (size_t)ch * 1024 * LDW1;
  for (int r_ = 0, it; xcd_item(r_, 4, T / 256, it); ++r_) {
    int brow = (it >> 2) * 256, bcol = (it & 3) * 256;
    int tid = tix_; asm volatile("" : "+v"(tid));
    f32x4 acc[8][4]; ACC256_ZERO(acc);
    g256_mainloop(tid, hb, LDP, Bt, LDW1, brow, bcol, 1024, acc);
    const bool isgate = bcol >= 768;
    EPI256_BEGIN
      float rs = rsqrtf(ssq1[row] * (1.f / 1024) + EPS);
#pragma unroll
      for (int i = 0; i < 16; ++i) { v[i] *= rs; if (isgate) v[i] = siluf(v[i]); }
      store16_bf(Z + (size_t)row * 1024 + col, v);
    EPI_END
  }
}
DI void phase_filter(const Params& p, int ch) {
  int tix_ = threadIdx.x; asm volatile("" : "+v"(tix_));
  const int tid = tix_;
  const float* h2t = (const float*)(p.ws + OFF_H2); float* kraw = (float*)(p.ws + OFF_KRAW);
  const float mind = -3.0701134573253945f, maxd = -15.350567286626973f;
  float* w3s = (float*)smem;
  for (int it = blockIdx.x; it < 192; it += gridDim.x) {
    int Lsel = it < 128 ? 0 : 1; int r = Lsel ? it - 128 : it; int L = Lsel ? 4096 : 8192; int nlb = L / 512;
    int cq = r & 3; r >>= 2; int lb = r % nlb, dir = r / nlb; int l = lb * 512 + tid; int cc0 = cq * 64, c0 = ch * 256 + cc0;
    const float* w3 = p.hy_f_w3 + (size_t)dir * 64 * 2048 + c0;
    for (int e = tid; e < 4096; e += NTHR) w3s[e] = w3[(size_t)(e >> 6) * 2048 + (e & 63)];
    const float* h2 = h2t + (Lsel ? (size_t)8192 * 2 * 64 : 0) + (size_t)dir * 64 * L + l;
    float hv[64];
#pragma unroll
    for (int j = 0; j < 64; ++j) hv[j] = h2[(size_t)j * L];
    __syncthreads();
    float* kr = kraw + (Lsel ? (size_t)16384 * 256 : 0); const int N = 2 * L; const float tl = (float)l / (float)(L - 1);
#pragma unroll 1
    for (int c4 = 0; c4 < 16; ++c4) {
      float a0 = 0.f, a1 = 0.f, a2 = 0.f, a3 = 0.f;
#pragma unroll
      for (int j = 0; j < 64; ++j) { f32x4 w = *(const f32x4*)(w3s + j * 64 + c4 * 4); a0 += hv[j] * w[0]; a1 += hv[j] * w[1]; a2 += hv[j] * w[2]; a3 += hv[j] * w[3]; }
      float av[4] = {a0, a1, a2, a3};
#pragma unroll
      for (int i = 0; i < 4; ++i) { int cl = c4 * 4 + i; float delta = fabsf(mind + (float)(c0 + cl) * ((maxd - mind) / 2047.f)); float k = av[i] * __expf(-tl * delta);
        float* row = kr + (size_t)(cc0 + cl) * N;
        if (dir == 0) row[l] = k; else if (l > 0) row[N - l] = k; else row[L] = 0.f; }
    }
    __syncthreads();
  }
}
DI float conv3_at(const bft* Z, int tok, int pos, int L, int col, float w0, float w1, float w2, float b) {
  float xm = pos > 0 ? bf2f(Z[(size_t)(tok - 1) * 1024 + col]) : 0.f, x0 = bf2f(Z[(size_t)tok * 1024 + col]), xp = pos < L - 1 ? bf2f(Z[(size_t)(tok + 1) * 1024 + col]) : 0.f;
  return xm * w0 + x0 * w1 + xp * w2 + b;
}
DI float2 twid(float r) { return float2{__builtin_amdgcn_cosf(r), -__builtin_amdgcn_sinf(r)}; }
DI void bfly_fwd(float2 a0, float2 a1, float2 a2, float2 a3, float r, float2& o0, float2& o1, float2& o2, float2& o3) {
  float2 t0 = {a0.x + a2.x, a0.y + a2.y}, t1 = {a0.x - a2.x, a0.y - a2.y}, t2 = {a1.x + a3.x, a1.y + a3.y}, t3 = {a1.x - a3.x, a1.y - a3.y};
  float2 b0 = {t0.x + t2.x, t0.y + t2.y}, b2 = {t0.x - t2.x, t0.y - t2.y}, b1 = {t1.x + t3.y, t1.y - t3.x}, b3 = {t1.x - t3.y, t1.y + t3.x};
  float2 w1 = twid(r), w2 = cmul(w1, w1), w3 = cmul(w2, w1);
  o0 = b0; o1 = cmul(b1, w1); o2 = cmul(b2, w2); o3 = cmul(b3, w3);
}
DI void bfly_inv(float2 s0, float2 s1, float2 s2, float2 s3, float r, float2& o0, float2& o1, float2& o2, float2& o3) {
  float2 w1 = twid(r), w2 = cmul(w1, w1), w3 = cmul(w2, w1);
  float2 c0 = s0, c1 = cmulc(s1, w1), c2 = cmulc(s2, w2), c3 = cmulc(s3, w3);
  float2 t0 = {c0.x + c2.x, c0.y + c2.y}, t1 = {c0.x - c2.x, c0.y - c2.y}, t2 = {c1.x + c3.x, c1.y + c3.y}, t3 = {c1.x - c3.x, c1.y - c3.y};
  o0 = float2{t0.x + t2.x, t0.y + t2.y}; o2 = float2{t0.x - t2.x, t0.y - t2.y}; o1 = float2{t1.x - t3.y, t1.y + t3.x}; o3 = float2{t1.x + t3.y, t1.y - t3.x};
}
template <int N, int NBT = 1> DI void fft_level_fwd(float2* z0, int tid, int lq) {
  const int Q = 1 << lq; const float invM = 1.f / (float)(4 << lq);
  for (int bb = tid; bb < NBT * (N / 4); bb += NTHR) { const int b = bb & (N / 4 - 1); float2* z = z0 + (bb / (N / 4)) * N; int j = b & (Q - 1), base = ((b >> lq) << (lq + 2)) + j; float2 o0, o1, o2, o3;
    bfly_fwd(z[base], z[base + Q], z[base + 2 * Q], z[base + 3 * Q], (float)j * invM, o0, o1, o2, o3);
    z[base] = o0; z[base + Q] = o1; z[base + 2 * Q] = o2; z[base + 3 * Q] = o3; }
  __syncthreads();
}
template <int N, int NBT = 1> DI void fft_level_inv(float2* z0, int tid, int lq) {
  const int Q = 1 << lq; const float invM = 1.f / (float)(4 << lq);
  for (int bb = tid; bb < NBT * (N / 4); bb += NTHR) { const int b = bb & (N / 4 - 1); float2* z = z0 + (bb / (N / 4)) * N; int j = b & (Q - 1), base = ((b >> lq) << (lq + 2)) + j; float2 o0, o1, o2, o3;
    bfly_inv(z[base], z[base + Q], z[base + 2 * Q], z[base + 3 * Q], (float)j * invM, o0, o1, o2, o3);
    z[base] = o0; z[base + Q] = o1; z[base + 2 * Q] = o2; z[base + 3 * Q] = o3; }
  __syncthreads();
}
template <int N, int NBT = 1> DI void fft_pair_fwd(float2* z0, int tid, int lq1) {
  const int lq2 = lq1 - 2, Q1 = 1 << lq1, Q2 = 1 << lq2; const float invM1 = 1.f / (float)(4 << lq1), invM2 = 1.f / (float)(4 << lq2);
  for (int gg = tid; gg < NBT * (N / 16); gg += NTHR) { const int g = gg & (N / 16 - 1); float2* z = z0 + (gg / (N / 16)) * N; const int jp = g & (Q2 - 1), base = ((g >> lq2) << (lq2 + 4)) + jp; float2 x[4][4];
#pragma unroll
    for (int q1 = 0; q1 < 4; ++q1)
#pragma unroll
      for (int q2 = 0; q2 < 4; ++q2) x[q1][q2] = z[base + q1 * Q1 + q2 * Q2];
#pragma unroll
    for (int q2 = 0; q2 < 4; ++q2) bfly_fwd(x[0][q2], x[1][q2], x[2][q2], x[3][q2], (float)(jp + q2 * Q2) * invM1, x[0][q2], x[1][q2], x[2][q2], x[3][q2]);
#pragma unroll
    for (int q1 = 0; q1 < 4; ++q1) bfly_fwd(x[q1][0], x[q1][1], x[q1][2], x[q1][3], (float)jp * invM2, x[q1][0], x[q1][1], x[q1][2], x[q1][3]);
#pragma unroll
    for (int q1 = 0; q1 < 4; ++q1)
#pragma unroll
      for (int q2 = 0; q2 < 4; ++q2) z[base + q1 * Q1 + q2 * Q2] = x[q1][q2]; }
  __syncthreads();
}
template <int N, int NBT = 1> DI void fft_pair_inv(float2* z0, int tid, int lq2) {
  const int lq1 = lq2 + 2, Q1 = 1 << lq1, Q2 = 1 << lq2; const float invM1 = 1.f / (float)(4 << lq1), invM2 = 1.f / (float)(4 << lq2);
  for (int gg = tid; gg < NBT * (N / 16); gg += NTHR) { const int g = gg & (N / 16 - 1); float2* z = z0 + (gg / (N / 16)) * N; const int jp = g & (Q2 - 1), base = ((g >> lq2) << (lq2 + 4)) + jp; float2 x[4][4];
#pragma unroll
    for (int q1 = 0; q1 < 4; ++q1)
#pragma unroll
      for (int q2 = 0; q2 < 4; ++q2) x[q1][q2] = z[base + q1 * Q1 + q2 * Q2];
#pragma unroll
    for (int q1 = 0; q1 < 4; ++q1) bfly_inv(x[q1][0], x[q1][1], x[q1][2], x[q1][3], (float)jp * invM2, x[q1][0], x[q1][1], x[q1][2], x[q1][3]);
#pragma unroll
    for (int q2 = 0; q2 < 4; ++q2) bfly_inv(x[0][q2], x[1][q2], x[2][q2], x[3][q2], (float)(jp + q2 * Q2) * invM1, x[0][q2], x[1][q2], x[2][q2], x[3][q2]);
#pragma unroll
    for (int q1 = 0; q1 < 4; ++q1)
#pragma unroll
      for (int q2 = 0; q2 < 4; ++q2) z[base + q1 * Q1 + q2 * Q2] = x[q1][q2]; }
  __syncthreads();
}
template <int N, int NBT = 1> DI void fft_level0_inv_mul(float2* z0, int tid, const float2* kh) {
  for (int bb = tid; bb < NBT * (N / 4); bb += NTHR) { const int b = bb & (N / 4 - 1); float2* z = z0 + (bb / (N / 4)) * N; const int base = b * 4; f32x4 k01 = *(const f32x4*)(kh + base), k23 = *(const f32x4*)(kh + base + 2); float2 o0, o1, o2, o3;
    bfly_inv(cmul(z[base], float2{k01[0], k01[1]}), cmul(z[base + 1], float2{k01[2], k01[3]}), cmul(z[base + 2], float2{k23[0], k23[1]}), cmul(z[base + 3], float2{k23[2], k23[3]}), 0.f, o0, o1, o2, o3);
    z[base] = o0; z[base + 1] = o1; z[base + 2] = o2; z[base + 3] = o3; }
  __syncthreads();
}
template <int LOGN, bool R2DONE = false> DI void fft_fwd(float2* z, int tid) {
  constexpr int N = 1 << LOGN;
  if constexpr (LOGN & 1) {
    if constexpr (!R2DONE) {
      for (int b = tid; b < N / 2; b += NTHR) { float2 a0 = z[b], a1 = z[b + N / 2]; float2 w = twid((float)b * (1.f / N));
        z[b] = float2{a0.x + a1.x, a0.y + a1.y}; z[b + N / 2] = cmul(float2{a0.x - a1.x, a0.y - a1.y}, w); }
      __syncthreads();
    }
    fft_pair_fwd<N>(z, tid, 10); fft_pair_fwd<N>(z, tid, 6); fft_level_fwd<N>(z, tid, 2); fft_level_fwd<N>(z, tid, 0);
  } else {
    if constexpr (!R2DONE) fft_level_fwd<N>(z, tid, 12);
    fft_pair_fwd<N>(z, tid, 10); fft_pair_fwd<N>(z, tid, 6); fft_level_fwd<N>(z, tid, 2); fft_level_fwd<N>(z, tid, 0);
  }
}
template <int LOGN> DI void fft_inv_mul(float2* z, int tid, const float2* kh) {
  constexpr int N = 1 << LOGN;
  fft_level0_inv_mul<N>(z, tid, kh);
  if constexpr (LOGN & 1) { fft_level_inv<N>(z, tid, 2); fft_pair_inv<N>(z, tid, 4); fft_pair_inv<N>(z, tid, 8); }
  else { fft_level_inv<N>(z, tid, 2); fft_pair_inv<N>(z, tid, 4); fft_pair_inv<N>(z, tid, 8); }
}
DI void fft2x13_fwd(float2* z, int tid) { constexpr int N = 8192;
  fft_pair_fwd<N, 2>(z, tid, 10); fft_pair_fwd<N, 2>(z, tid, 6); fft_level_fwd<N, 2>(z, tid, 2); fft_level_fwd<N, 2>(z, tid, 0); }
DI void fft2x13_inv_mul(float2* z, int tid, const float2* kh) { constexpr int N = 8192;
  fft_level0_inv_mul<N, 2>(z, tid, kh); fft_level_inv<N, 2>(z, tid, 2); fft_pair_inv<N, 2>(z, tid, 4); fft_pair_inv<N, 2>(z, tid, 8); }
template <int LOGN> DI void filtfft_item(const Params& p, int ch, int cc, const float* kr, float2* kh) {
  constexpr int N = 1 << LOGN; int tid = threadIdx.x; asm volatile("" : "+v"(tid)); float2* z = (float2*)smem; float* redbuf = (float*)(smem + 131072);
  float ss = 0.f;
  if constexpr (LOGN & 1) {
    for (int i = tid; i < N / 2; i += NTHR) { float k0 = kr[i], k1 = kr[i + N / 2]; ss += k0 * k0 + k1 * k1; float2 w = twid((float)i * (1.f / N)); float d = k0 - k1;
      z[i] = float2{k0 + k1, 0.f}; z[i + N / 2] = float2{d * w.x, d * w.y}; }
  } else {
    constexpr int Q = N / 4;
    for (int i = tid; i < Q; i += NTHR) { float k0 = kr[i], k1 = kr[i + Q], k2 = kr[i + 2 * Q], k3 = kr[i + 3 * Q]; ss += k0 * k0 + k1 * k1 + k2 * k2 + k3 * k3; float2 o0, o1, o2, o3;
      bfly_fwd(float2{k0, 0.f}, float2{k1, 0.f}, float2{k2, 0.f}, float2{k3, 0.f}, (float)i * (1.f / N), o0, o1, o2, o3);
      z[i] = o0; z[i + Q] = o1; z[i + 2 * Q] = o2; z[i + 3 * Q] = o3; }
  }
  ss = wave_sum(ss); if ((tid & 63) == 0) redbuf[tid >> 6] = ss;
  __syncthreads();
  float tot = 0.f;
#pragma unroll
  for (int w = 0; w < 8; ++w) tot += redbuf[w];
  const float nrm = rsqrtf(tot + EPS) * (1.f / N), bias = p.hy_bias[ch * 256 + cc] * (1.f / N);
  fft_fwd<LOGN, true>(z, tid);
  for (int i = tid; i < N; i += NTHR) { float2 v = z[i]; kh[i] = float2{v.x * nrm + bias, v.y * nrm}; }
  __syncthreads();
}
DI void phase_vx(const Params& p, int ch) {
  int tix_ = threadIdx.x; asm volatile("" : "+v"(tix_));
  const bft* Z = (const bft*)(p.ws + OFF_U); bft* vxT = (bft*)(p.ws + OFF_VXT);
  const float* kraw = (const float*)(p.ws + OFF_KRAW); float2* khat = (float2*)(p.ws + OFF_KHAT);
  const int tid = tix_; float* tile = (float*)smem;
  const float* cw = p.hy_conv_w; const float* cb = p.hy_conv_b;
  for (int it = blockIdx.x; it < 512; it += gridDim.x) {
    int cc = it & 255;
    if (it < 256) filtfft_item<14>(p, ch, cc, kraw + (size_t)cc * 16384, khat + (size_t)cc * 16384);
    else filtfft_item<13>(p, ch, cc, kraw + (size_t)16384 * 256 + (size_t)cc * 8192, khat + (size_t)16384 * 256 + (size_t)cc * 8192);
  }
  for (int it = blockIdx.x; it < T / 64; it += gridDim.x) {
    const int tok0 = it * 64;
#pragma unroll 1
    for (int rr = 0; rr < 4; ++rr) { int e = tid + rr * 512; int tl = e >> 5, cg = e & 31; int tok = tok0 + tl, cc = cg * 8, c = ch * 256 + cc; int pos = tok_pos(tok), L = tok_len(tok);
      const bft* zr = Z + (size_t)tok * 1024; u32x4 zero = {0, 0, 0, 0};
      u32x4 x1m = pos > 0 ? *(const u32x4*)(zr - 1024 + 256 + cc) : zero, x10 = *(const u32x4*)(zr + 256 + cc), x1p = pos < L - 1 ? *(const u32x4*)(zr + 1024 + 256 + cc) : zero;
      u32x4 vm = pos > 0 ? *(const u32x4*)(zr - 1024 + 512 + cc) : zero, v0 = *(const u32x4*)(zr + 512 + cc), vp = pos < L - 1 ? *(const u32x4*)(zr + 1024 + 512 + cc) : zero;
#pragma unroll
      for (int i = 0; i < 8; ++i) { int sh = (i & 1) ? 0 : 16; unsigned msk = 0xffff0000u; int w = i >> 1;
        float a = __uint_as_float((x1m[w] << sh) & msk), b = __uint_as_float((x10[w] << sh) & msk), d = __uint_as_float((x1p[w] << sh) & msk);
        float e0 = __uint_as_float((vm[w] << sh) & msk), e1 = __uint_as_float((v0[w] << sh) & msk), e2 = __uint_as_float((vp[w] << sh) & msk);
        int ci = c + i;
        float x1 = a * cw[2048 + ci] + b * cw[6144 + 2048 + ci] + d * cw[12288 + 2048 + ci] + cb[2048 + ci];
        float vv = e0 * cw[4096 + ci] + e1 * cw[6144 + 4096 + ci] + e2 * cw[12288 + 4096 + ci] + cb[4096 + ci];
        tile[tl * 257 + cc + i] = vv * x1; } }
    __syncthreads();
    { int cl = tid >> 1, th = (tid & 1) * 32; bft* dst = vxT + (size_t)cl * T + tok0 + th;
#pragma unroll
      for (int q = 0; q < 4; ++q) { u32x4 o;
#pragma unroll
        for (int k = 0; k < 4; ++k) o[k] = pack2(tile[(th + q * 8 + 2 * k) * 257 + cl], tile[(th + q * 8 + 2 * k + 1) * 257 + cl]);
        *(u32x4*)(dst + q * 8) = o; } }
    __syncthreads();
  }
}
template <int LOGN> DI void fftconv_item(bft* xa, bft* xb, const float2* kh) {
  constexpr int N = 1 << LOGN, L = N / 2; int tid = threadIdx.x; asm volatile("" : "+v"(tid)); float2* z = (float2*)smem;
  if constexpr (LOGN & 1) {
    for (int i = 2 * tid; i < L; i += 2 * NTHR) { unsigned wa = *(const unsigned*)(xa + i), wb = *(const unsigned*)(xb + i);
      float2 x0 = {__uint_as_float(wa << 16), __uint_as_float(wb << 16)}, x1 = {__uint_as_float(wa & 0xffff0000u), __uint_as_float(wb & 0xffff0000u)};
      z[i] = x0; z[i + 1] = x1;
      z[L + i] = cmul(x0, twid((float)i * (1.f / N))); z[L + i + 1] = cmul(x1, twid((float)(i + 1) * (1.f / N))); }
  } else {
    constexpr int Q = N / 4; const float2 zero = {0.f, 0.f};
    for (int i = 2 * tid; i < Q; i += 2 * NTHR) { unsigned wa = *(const unsigned*)(xa + i), wb = *(const unsigned*)(xb + i), wc = *(const unsigned*)(xa + Q + i), wd = *(const unsigned*)(xb + Q + i);
#pragma unroll
      for (int e = 0; e < 2; ++e) { float2 a0 = e ? float2{__uint_as_float(wa & 0xffff0000u), __uint_as_float(wb & 0xffff0000u)} : float2{__uint_as_float(wa << 16), __uint_as_float(wb << 16)};
        float2 a1 = e ? float2{__uint_as_float(wc & 0xffff0000u), __uint_as_float(wd & 0xffff0000u)} : float2{__uint_as_float(wc << 16), __uint_as_float(wd << 16)};
        float2 o0, o1, o2, o3; bfly_fwd(a0, a1, zero, zero, (float)(i + e) * (1.f / N), o0, o1, o2, o3);
        z[i + e] = o0; z[i + e + Q] = o1; z[i + e + 2 * Q] = o2; z[i + e + 3 * Q] = o3; } }
  }
  __syncthreads();
  fft_fwd<LOGN, true>(z, tid);
  fft_inv_mul<LOGN>(z, tid, kh);
  if constexpr (LOGN & 1) {
    for (int i = 2 * tid; i < L; i += 2 * NTHR) { float2 v0 = z[i], v1 = z[i + 1];
      float2 c0 = cmulc(z[L + i], twid((float)i * (1.f / N))), c1 = cmulc(z[L + i + 1], twid((float)(i + 1) * (1.f / N))); v0.x += c0.x; v0.y += c0.y; v1.x += c1.x; v1.y += c1.y;
      *(unsigned*)(xa + i) = pack2(v0.x, v1.x); *(unsigned*)(xb + i) = pack2(v0.y, v1.y); }
  } else {
    constexpr int Q = N / 4;
    for (int i = 2 * tid; i < Q; i += 2 * NTHR) { float2 r0[2], r1[2];
#pragma unroll
      for (int e = 0; e < 2; ++e) { float2 o2, o3; bfly_inv(z[i + e], z[i + e + Q], z[i + e + 2 * Q], z[i + e + 3 * Q], (float)(i + e) * (1.f / N), r0[e], r1[e], o2, o3); }
      *(unsigned*)(xa + i) = pack2(r0[0].x, r0[1].x); *(unsigned*)(xb + i) = pack2(r0[0].y, r0[1].y);
      *(unsigned*)(xa + Q + i) = pack2(r1[0].x, r1[1].x); *(unsigned*)(xb + Q + i) = pack2(r1[0].y, r1[1].y); }
  }
  __syncthreads();
}
DI void fftconv2_item(bft* x, const float2* kh) {
  constexpr int N = 8192, L = 4096; int tid = threadIdx.x; asm volatile("" : "+v"(tid)); float2* z0 = (float2*)smem;
  for (int ii = 2 * tid; ii < 2 * L; ii += 2 * NTHR) { const int sel = ii >= L ? 1 : 0, i = ii - sel * L; bft* xa = x + sel * 2 * L; bft* xb = xa + L; float2* z = z0 + sel * N;
    unsigned wa = *(const unsigned*)(xa + i), wb = *(const unsigned*)(xb + i);
    float2 x0 = {__uint_as_float(wa << 16), __uint_as_float(wb << 16)}, x1 = {__uint_as_float(wa & 0xffff0000u), __uint_as_float(wb & 0xffff0000u)};
    z[i] = x0; z[i + 1] = x1; z[L + i] = cmul(x0, twid((float)i * (1.f / N))); z[L + i + 1] = cmul(x1, twid((float)(i + 1) * (1.f / N))); }
  __syncthreads();
  fft2x13_fwd(z0, tid);
  fft2x13_inv_mul(z0, tid, kh);
  for (int ii = 2 * tid; ii < 2 * L; ii += 2 * NTHR) { const int sel = ii >= L ? 1 : 0, i = ii - sel * L; bft* xa = x + sel * 2 * L; bft* xb = xa + L; float2* z = z0 + sel * N;
    float2 v0 = z[i], v1 = z[i + 1];
    float2 c0 = cmulc(z[L + i], twid((float)i * (1.f / N))), c1 = cmulc(z[L + i + 1], twid((float)(i + 1) * (1.f / N))); v0.x += c0.x; v0.y += c0.y; v1.x += c1.x; v1.y += c1.y;
    *(unsigned*)(xa + i) = pack2(v0.x, v1.x); *(unsigned*)(xb + i) = pack2(v0.y, v1.y); }
  __syncthreads();
}
DI void phase_conv(const Params& p, int ch) {
  int tix_ = threadIdx.x; asm volatile("" : "+v"(tix_));
  bft* vxT = (bft*)(p.ws + OFF_VXT); const float2* khat = (const float2*)(p.ws + OFF_KHAT);
  for (int it = blockIdx.x; it < 768; it += gridDim.x) {
    int cc = it & 255; bft* row = vxT + (size_t)cc * T;
    if (it < 256) fftconv_item<14>(row, row + 8192, khat + (size_t)cc * 16384);
    else { int pq = (it - 256) >> 8; fftconv2_item(row + TP + (4 * pq) * 4096, khat + (size_t)16384 * 256 + (size_t)cc * 8192); }
  }
}
DI void phase_gate(const Params& p, int ch) {
  int tix_ = threadIdx.x; asm volatile("" : "+v"(tix_));
  const bft* Z = (const bft*)(p.ws + OFF_U); const bft* yT = (const bft*)(p.ws + OFF_VXT); bft* G1 = (bft*)(p.ws + OFF_G1H) + (ch & 3) * 256;
  const int tid = tix_; float* tile = (float*)smem;
  const float* cw = p.hy_conv_w; const float* cb = p.hy_conv_b;
  for (int it = blockIdx.x; it < T / 64; it += gridDim.x) {
    const int tok0 = it * 64;
    { int cl = tid >> 1, th = (tid & 1) * 32; const bft* s = yT + (size_t)cl * T + tok0 + th;
#pragma unroll
      for (int q = 0; q < 4; ++q) { u32x4 v = *(const u32x4*)(s + q * 8);
#pragma unroll
        for (int k = 0; k < 4; ++k) { tile[cl * 65 + th + q * 8 + 2 * k] = __uint_as_float(v[k] << 16); tile[cl * 65 + th + q * 8 + 2 * k + 1] = __uint_as_float(v[k] & 0xffff0000u); } } }
    __syncthreads();
#pragma unroll 1
    for (int rr = 0; rr < 4; ++rr) { int e = tid + rr * 512; int tl = e >> 5, cg = e & 31; int tok = tok0 + tl, cc = cg * 8, c = ch * 256 + cc; int pos = tok_pos(tok), L = tok_len(tok);
      const bft* zr = Z + (size_t)tok * 1024; u32x4 zero = {0, 0, 0, 0};
      u32x4 xm = pos > 0 ? *(const u32x4*)(zr - 1024 + cc) : zero, x0 = *(const u32x4*)(zr + cc), xp = pos < L - 1 ? *(const u32x4*)(zr + 1024 + cc) : zero, gt = *(const u32x4*)(zr + 768 + cc);
      float o[8];
#pragma unroll
      for (int i = 0; i < 8; ++i) { int sh = (i & 1) ? 0 : 16; unsigned msk = 0xffff0000u; int w = i >> 1;
        float a = __uint_as_float((xm[w] << sh) & msk), b = __uint_as_float((x0[w] << sh) & msk), d = __uint_as_float((xp[w] << sh) & msk), g = __uint_as_float((gt[w] << sh) & msk);
        int ci = c + i; float xc = a * cw[ci] + b * cw[6144 + ci] + d * cw[12288 + ci] + cb[ci];
        o[i] = tile[(cc + i) * 65 + tl] * xc * g; }
      u32x4 w = {pack2(o[0], o[1]), pack2(o[2], o[3]), pack2(o[4], o[5]), pack2(o[6], o[7])};
      *(u32x4*)(G1 + (size_t)tok * 1024 + cc) = w; }
    __syncthreads();
  }
}
DI void phase_outproj1(const Params& p, int hh) {
  int tix_ = threadIdx.x; asm volatile("" : "+v"(tix_));
  const bft* G1 = (const bft*)(p.ws + OFF_G1H); bft* hb3 = (bft*)(p.ws + OFF_HB3);
  const bft* Bt = (const bft*)(p.ws + OFF_Wout1) + hh * 1024;
  for (int r_ = 0, it; xcd_item(r_, 4, T / 256, it); ++r_) {
    int brow = (it >> 2) * 256, bcol = (it & 3) * 256;
    int tid = tix_; asm volatile("" : "+v"(tid));
    f32x4 acc[8][4]; ACC256_ZERO(acc);
    g256_mainloop(tid, G1, 1024, Bt, LDW2, brow, bcol, 1024, acc);
    EPI256_BEGIN
      float h[16]; float* hp = p.out + (size_t)row * 1024 + col; load16_f(hp, h);
#pragma unroll
      for (int i = 0; i < 16; ++i) h[i] += v[i];
      store16_f(hp, h); if (hh == 1) store16_bf(hb3 + (size_t)row * 1024 + col, h);
    EPI_END
  }
}
DI void phase_final(const Params& p) {
  int tix_ = threadIdx.x; asm volatile("" : "+v"(tix_));
  const int lane = tix_ & 63, wid = tix_ >> 6; const float* ssq = (const float*)(p.ws + OFF_SSQF);
  for (int it = blockIdx.x; it < T / 8; it += gridDim.x) {
    int tok = it * 8 + wid; float rs = rsqrtf(ssq[tok] * (1.f / 1024) + EPS); float* hr = p.out + (size_t)tok * 1024;
    for (int i = 0; i < 4; ++i) { f32x4 v = *(f32x4*)(hr + i * 256 + lane * 4); f32x4 g = *(const f32x4*)(p.final_g + i * 256 + lane * 4);
      v[0] *= rs * g[0]; v[1] *= rs * g[1]; v[2] *= rs * g[2]; v[3] *= rs * g[3]; *(f32x4*)(hr + i * 256 + lane * 4) = v; }
  }
}

__global__ void __launch_bounds__(NTHR) mega(Params p) {
  cg::grid_group grid = cg::this_grid();
  if (threadIdx.x == 0) xb_words = make_uint4(0u, 0u, 0u, 0u);
  __syncthreads();
  XcdBarrier xb = xcd_barrier_post((unsigned*)(p.ws + OFF_BAR), (volatile LAS unsigned*)&xb_words);
#define GSYNC() xcd_barrier(xb)
  phase_prep(p); GSYNC();
  if (threadIdx.x == 0) { unsigned idx = 0; for (unsigned j = 0; j < xb.x; ++j) idx += xb_ld(&xb.bar[XB_XCNT(j)]) > 0u ? 1u : 0u; xb_words.w = idx; }
  __syncthreads();
  phase_inproj0(p); GSYNC();
  if (p.out == nullptr) grid.sync();
  phase_mlaprep(p); phase_s5gen(p); GSYNC();
  phase_s5step1(p); GSYNC();
  phase_s5scan(p); GSYNC();
  phase_s5step3(p); GSYNC();
  for (int sg = 0; sg < 3; ++sg) { phase_upproj(p, sg); GSYNC(); phase_attn(p, sg); GSYNC(); }
  phase_glu(p); GSYNC();
  phase_outproj0(p); GSYNC();
  phase_ple(p, 0, (const bft*)(p.ws + OFF_U), (bft*)(p.ws + OFF_A), LDP, (float*)(p.ws + OFF_SSQ1)); GSYNC();
  convert_p(p, 1);
  for (int ch = 0; ch < 8; ++ch) {
    if (ch == 4) phase_outproj1(p, 0);
    phase_inproj1(p, ch); phase_filter(p, ch); GSYNC();
    phase_vx(p, ch); GSYNC();
    phase_conv(p, ch); GSYNC();
    phase_gate(p, ch); GSYNC();
  }
  phase_outproj1(p, 1); GSYNC();
  phase_ple(p, 1, (const bft*)(p.ws + OFF_HB3), nullptr, 1024, (float*)(p.ws + OFF_SSQF)); GSYNC();
  phase_final(p);
}

extern "C" void kernel_launch(void* const* d_in, const int* in_sizes, int n_in, void* d_out, int out_size, void* d_ws, size_t ws_size, hipStream_t stream) {
  static int grid_blocks = 0;
  if (!grid_blocks) {
    (void)hipFuncSetAttribute((const void*)mega, hipFuncAttributeMaxDynamicSharedMemorySize, (int)LDS_BYTES);
    int dev = 0, cus = 0, per_cu = 0;
    (void)hipGetDevice(&dev);
    (void)hipDeviceGetAttribute(&cus, hipDeviceAttributeMultiprocessorCount, dev);
    (void)hipOccupancyMaxActiveBlocksPerMultiprocessor(&per_cu, mega, NTHR, LDS_BYTES);
    if (per_cu < 1) per_cu = 1;
    if (per_cu > 1) per_cu = 1;
    grid_blocks = cus * per_cu;
    if (ws_size < OFF_BAR + XCD_BAR_WORDS * 4) fprintf(stderr, "ws too small: %zu < %zu\n", ws_size, (size_t)WS_END);
  }
  Params p{};
  const float** pp = (const float**)&p;
  for (int i = 0; i < 36; ++i) pp[i] = (const float*)d_in[i];
  p.out = (float*)d_out; p.ws = (char*)d_ws;
  for (int i = 0; i < 32; ++i) p.rope_inv[i] = 1.0 / pow(10000.0, (double)(2 * i) / 64.0);
  (void)hipMemsetAsync((char*)d_ws + OFF_BAR, 0, XCD_BAR_WORDS * sizeof(unsigned), stream);
  void* args[] = {&p};
  hipError_t e = hipLaunchCooperativeKernel((void*)mega, dim3(grid_blocks), dim3(NTHR), args, LDS_BYTES, stream);
  if (e != hipSuccess) fprintf(stderr, "cooperative launch failed: %s (grid %d)\n", hipGetErrorString(e), grid_blocks);
}
```

```cpp
#include <hip/hip_runtime.h>
#include <hip/hip_bf16.h>
#include <hip/hip_cooperative_groups.h>
#include <cstdio>
#include <cmath>
namespace cg = cooperative_groups;

#define DI __device__ __forceinline__
typedef unsigned short bft;
using bf16x8 = __attribute__((ext_vector_type(8))) short;
using s16x4  = __attribute__((ext_vector_type(4))) short;
using f32x4  = __attribute__((ext_vector_type(4))) float;
using f32x16 = __attribute__((ext_vector_type(16))) float;
using u32x4  = __attribute__((ext_vector_type(4))) unsigned;
using u32x2  = __attribute__((ext_vector_type(2))) unsigned;

constexpr int T = 49152, TP = 16384, DM = 1024;
constexpr float EPS = 1e-6f;
constexpr int NTHR = 512;
constexpr size_t LDS_BYTES = 147456;

constexpr int LDP = 1088, LDW1 = 1088, LDW2 = 2112, LDWQ = 448, LDWS = 320;
constexpr size_t SZ_W0t = 3840ull * LDW1 * 2, SZ_Wq = 1536ull * LDWQ * 2, SZ_Wkv = 2048ull * LDWS * 2, SZ_Wsq = 1024ull * LDW1 * 2;
constexpr size_t SZ_Wout = 1024ull * LDW2 * 2, SZ_Wpw = 1024ull * LDWS * 2, SZ_W1t = 8192ull * LDW1 * 2;
constexpr size_t OFF_W0t = 0, OFF_Wq = OFF_W0t + SZ_W0t, OFF_Wkv = OFF_Wq + SZ_Wq, OFF_Wglu = OFF_Wkv + SZ_Wkv, OFF_Wout0 = OFF_Wglu + SZ_Wsq;
constexpr size_t OFF_Wpg = OFF_Wout0 + SZ_Wout, OFF_Wpw = OFF_Wpg + 2 * SZ_Wsq, OFF_W1t = OFF_Wpw + 2 * SZ_Wpw, OFF_Wout1 = OFF_W1t + SZ_W1t;
constexpr size_t OFF_R0 = OFF_Wout1 + SZ_Wout, OFF_SSQ1 = OFF_R0 + T * 4, OFF_SSQF = OFF_SSQ1 + T * 4, OFF_HYSSQ = OFF_SSQF + T * 4;
constexpr size_t OFF_ROPE = OFF_HYSSQ + 2 * 2048 * 4, OFF_H2 = OFF_ROPE + 8192ull * 64 * 4;
constexpr size_t SZ_H2 = (8192ull + 4096) * 2 * 64 * 4;
constexpr size_t OFF_A = (OFF_H2 + SZ_H2 + 255) / 256 * 256;
constexpr size_t SZ_TB = (size_t)T * 1024 * 2;
constexpr size_t OFF_U = OFF_A + (size_t)T * LDP * 2;
constexpr size_t OFF_LAT = OFF_U + SZ_TB;
constexpr size_t SZ_LAT = (size_t)T * 704 * 2;
constexpr size_t OFF_G0 = OFF_LAT + SZ_LAT;
constexpr size_t SZ_G0 = (size_t)T * 2048 * 2;
constexpr size_t WS_END = OFF_G0 + SZ_G0;
constexpr size_t OFF_KRAW = OFF_LAT + 32ull * 1024 * 1024, SZ_KRAW = (16384ull + 8192) * 256 * 4;
static_assert(OFF_KRAW + SZ_KRAW <= OFF_G0, "kraw fits in LAT region");
constexpr size_t OFF_KHAT = OFF_G0, SZ_KHAT = (16384ull + 8192) * 256 * 8;
constexpr size_t OFF_VXT = OFF_KHAT + SZ_KHAT, SZ_VXT = (size_t)T * 256 * 4;
constexpr size_t OFF_G1H = OFF_VXT + SZ_VXT, SZ_G1H = (size_t)T * 1024 * 2;
static_assert(OFF_G1H + SZ_G1H <= WS_END, "layer1 layout");
constexpr size_t OFF_HB3 = OFF_U;
constexpr size_t OFF_BAR = (WS_END + 255) / 256 * 256;
static_assert(OFF_BAR + 16384 <= 536870912ull, "workspace budget");

#define XB_TMO      128
#define XB_XCNT(j)  (256  + 64 * (j))
#define XB_XSUB(j)  (1280 + 64 * (j))
#define XB_XGEN(j)  (2304 + 64 * (j))
#define XB_TOP      3328
#define XB_TOPGEN   3392
#define XCD_BAR_WORDS 3456
#define XB_SPIN_CAP (1u << 22)
#define LAS __attribute__((address_space(3)))
__device__ __forceinline__ unsigned xb_ld(unsigned* p)              { return __hip_atomic_load(p, __ATOMIC_RELAXED, __HIP_MEMORY_SCOPE_AGENT); }
__device__ __forceinline__ unsigned xb_add(unsigned* p, unsigned v) { return __hip_atomic_fetch_add(p, v, __ATOMIC_RELAXED, __HIP_MEMORY_SCOPE_AGENT); }
__device__ __forceinline__ unsigned xb_xcc_id() { return (unsigned)__builtin_amdgcn_s_getreg((3 << 11) | 20) & 0xFu; }
#define XB_SPIN(cond, bar) do { unsigned _sp = 0; while (cond) { __builtin_amdgcn_s_sleep(1); \
    if ((++_sp & 255u) == 0u) { if (xb_ld(&(bar)[XB_TMO])) break; if (_sp > XB_SPIN_CAP) { atomicAdd(&(bar)[XB_TMO], 1u); break; } } } } while (0)
struct XcdBarrier { unsigned* bar; unsigned x; volatile LAS unsigned* st; };
__device__ __forceinline__ XcdBarrier xcd_barrier_post(unsigned* bar, volatile LAS unsigned* st) {
  XcdBarrier b; b.bar = bar; b.x = (unsigned)__builtin_amdgcn_readfirstlane((int)xb_xcc_id()); b.st = st;
  if (threadIdx.x == 0) st[2] = xb_add(&bar[XB_XCNT(b.x)], 1u);
  return b;
}
__device__ __forceinline__ void xcd_barrier_complete(unsigned* bar, unsigned x, unsigned& nloc, unsigned& nx) {
  const unsigned G = gridDim.x * gridDim.y * gridDim.z;
  unsigned sum, cnt, mine, sp = 0u;
  for (;;) {
    sum = 0u; cnt = 0u; mine = 0u;
#pragma unroll
    for (unsigned j = 0; j < 16; ++j) { const unsigned c = xb_ld(&bar[XB_XCNT(j)]); sum += c; cnt += (c > 0u) ? 1u : 0u; mine = (j == x) ? c : mine; }
    if (sum == G) break;
    __builtin_amdgcn_s_sleep(1);
    if ((++sp & 255u) == 0u) { if (xb_ld(&bar[XB_TMO])) break; if (sp > XB_SPIN_CAP) { atomicAdd(&bar[XB_TMO], 1u); break; } }
  }
  nloc = mine > 0u ? mine : 1u; nx = cnt > 0u ? cnt : 1u;
}
__device__ __forceinline__ void xcd_barrier(const XcdBarrier& b) {
  asm volatile("s_waitcnt vmcnt(0)" ::: "memory");
  __syncthreads();
  if (threadIdx.x == 0) {
    unsigned* bar = b.bar; unsigned bx = b.x; asm volatile("" : "+s"(bx));
    __builtin_amdgcn_s_waitcnt(0);
    unsigned nloc = b.st[0], nx = b.st[1];
    if (nloc == 0u) { xcd_barrier_complete(bar, bx, nloc, nx); b.st[0] = nloc; b.st[1] = nx; }
    const unsigned old = xb_add(&bar[XB_XSUB(bx)], 1u);
    const unsigned gen = old / nloc;
    if (old + 1u == (gen + 1u) * nloc) {
      __builtin_amdgcn_fence(__ATOMIC_RELEASE, "agent");
      asm volatile("s_waitcnt vmcnt(0)" ::: "memory");
      const unsigned og = xb_add(&bar[XB_TOP], 1u);
      const unsigned tg = og / nx;
      if (og + 1u == (tg + 1u) * nx) xb_add(&bar[XB_TOPGEN], 1u);
      else XB_SPIN(xb_ld(&bar[XB_TOPGEN]) == tg, bar);
      __builtin_amdgcn_fence(__ATOMIC_ACQUIRE, "agent");
      xb_add(&bar[XB_XGEN(bx)], 1u);
      asm volatile("s_waitcnt vmcnt(0)" ::: "memory");
    } else {
      XB_SPIN(xb_ld(&bar[XB_XGEN(bx)]) == gen, bar);
      __builtin_amdgcn_fence(__ATOMIC_ACQUIRE, "agent");
      asm volatile("s_waitcnt vmcnt(0)" ::: "memory");
    }
  }
  __syncthreads();
}

struct Params {
  const float *x_prompt, *x_sample, *p_prompt, *p_sample, *norm_g, *final_g, *ple_w, *ple_gate_w, *ab_w_in, *ab_w_out;
  const float *s5_a_re, *s5_a_im, *s5_log_dt, *s5_b_re, *s5_b_im, *s5_c_re, *s5_c_im, *s5_d, *s5_glu_w, *s5_glu_b;
  const float *mla_q_norm, *mla_w_q_up, *mla_kv_norm, *mla_w_kv_up, *hy_w_in, *hy_w_out, *hy_conv_w, *hy_conv_b;
  const float *hy_f_w1, *hy_f_b1, *hy_f_freq1, *hy_f_w2, *hy_f_b2, *hy_f_freq2, *hy_f_w3, *hy_bias;
  float* out; char* ws;
  double rope_inv[32];
};

extern __shared__ __attribute__((aligned(16))) char smem[];

DI bft f2bf(float x) { unsigned u = __float_as_uint(x); u += 0x7fffu + ((u >> 16) & 1u); return (bft)(u >> 16); }
DI float bf2f(bft h) { return __uint_as_float(((unsigned)h) << 16); }
DI unsigned pack2(float a, float b) { return (unsigned)f2bf(a) | ((unsigned)f2bf(b) << 16); }
DI float2 cmul(float2 a, float2 b) { return float2{a.x * b.x - a.y * b.y, a.x * b.y + a.y * b.x}; }
DI float2 cmulc(float2 a, float2 b) { return float2{a.x * b.x + a.y * b.y, a.y * b.x - a.x * b.y}; }
DI float sigm(float x) { return 1.f / (1.f + __expf(-x)); }
DI float siluf(float x) { return x * sigm(x); }
DI float geluf(float x) { float z = 0.7978845608028654f * (x + 0.044715f * x * x * x); float t = 1.f - 2.f / (1.f + __expf(2.f * z)); return 0.5f * x * (1.f + t); }
DI void sincos_d(double ang, float& s, float& c) { double rev = ang * 0.15915494309189535; rev -= rint(rev); float r = (float)rev; s = __builtin_amdgcn_sinf(r); c = __builtin_amdgcn_cosf(r); }
DI float sin_f(float ang) { float rev = ang * 0.15915494309189535f; rev -= rintf(rev); return __builtin_amdgcn_sinf(rev); }
DI float wave_sum(float v) { for (int o = 32; o > 0; o >>= 1) v += __shfl_xor(v, o); return v; }
DI int tok_pos(int tok) { return tok < TP ? (tok & 8191) : (tok & 4095); }
DI int tok_len(int tok) { return tok < TP ? 8192 : 4096; }
__shared__ uint4 xb_words;
DI bool xcd_item(int r, int GS, int ngroups, int& item) {
  const int nb = (int)xb_words.x, nx = (int)xb_words.y, j = (int)xb_words.z, xcd = (int)xb_words.w;
  const int li = r * nb + j, gl = li / GS, gi = gl * nx + xcd;
  if (gi >= ngroups) return false;
  item = gi * GS + (li - gl * GS); return true;
}
DI const float* xrow(const Params& p, int tok) { return tok < TP ? p.x_prompt + (size_t)tok * 1024 : p.x_sample + (size_t)(tok - TP) * 1024; }

struct TrJob { const float* src; int ldsrc, srccol0, k0; bft* dst; int lddst, dstrow0; const float* g; };
DI bool get_trjob(const Params& p, int j, TrJob& o) {
  const int c1 = 944, c2 = c1 + 144, c3 = c2 + 128, c4 = c3 + 256, c5 = c4 + 512, c6 = c5 + 512, c7 = c6 + 128, c8 = c7 + 2048, c9 = c8 + 512;
  int K, N, t; o.g = nullptr;
  if (j < c1) { t = j; K = 1024; N = 3776; o.src = p.ab_w_in; o.dst = (bft*)(p.ws + OFF_W0t); o.g = p.norm_g; }
  else if (j < c2) { t = j - c1; K = 384; N = 1536; o.src = p.mla_w_q_up; o.dst = (bft*)(p.ws + OFF_Wq); o.g = p.mla_q_norm; }
  else if (j < c3) { t = j - c2; K = 256; N = 2048; o.src = p.mla_w_kv_up; o.dst = (bft*)(p.ws + OFF_Wkv); o.g = p.mla_kv_norm; }
  else if (j < c4) { t = j - c3; K = 1024; N = 1024; o.src = p.s5_glu_w; o.dst = (bft*)(p.ws + OFF_Wglu); }
  else if (j < c5) { t = j - c4; K = 2048; N = 1024; o.src = p.ab_w_out; o.dst = (bft*)(p.ws + OFF_Wout0); }
  else if (j < c6) { t = j - c5; int l = t >> 8; t &= 255; K = 1024; N = 1024; o.src = p.ple_gate_w + (size_t)l * 1024 * 1024; o.dst = (bft*)(p.ws + OFF_Wpg + l * SZ_Wsq); }
  else if (j < c7) { t = j - c6; int l = t >> 6; t &= 63; K = 256; N = 1024; o.src = p.ple_w + (size_t)l * 256 * 1024; o.dst = (bft*)(p.ws + OFF_Wpw + l * SZ_Wpw); }
  else if (j < c8) { t = j - c7; K = 1024; N = 8192; o.src = p.hy_w_in; o.dst = (bft*)(p.ws + OFF_W1t); o.g = p.norm_g + 1024; }
  else if (j < c9) { t = j - c8; K = 2048; N = 1024; o.src = p.hy_w_out; o.dst = (bft*)(p.ws + OFF_Wout1); }
  else return false;
  int nt = N / 64; int kt = t / nt, ntile = t % nt;
  o.ldsrc = N; o.srccol0 = ntile * 64; o.k0 = kt * 64; o.lddst = K + 64; o.dstrow0 = ntile * 64;
  if (j >= c7 && j < c8) { int n0 = ntile * 64, part = n0 >> 11, rem = n0 & 2047, ch = rem >> 8, cc0 = rem & 255; o.dstrow0 = ch * 1024 + part * 256 + cc0; }
  return true;
}
constexpr int N_TRJOBS = 944 + 144 + 128 + 256 + 512 + 512 + 128 + 2048 + 512;

DI void phase_prep(const Params& p) {
  int tix_ = threadIdx.x; asm volatile("" : "+v"(tix_));
  const int tid = tix_, lane = tid & 63, wid = tid >> 6;
  float* tile = (float*)smem;
  for (int j = blockIdx.x; j < N_TRJOBS; j += gridDim.x) {
    TrJob jb; get_trjob(p, j, jb);
    { int r = tid >> 6, c = tid & 63;
      for (int i = 0; i < 8; ++i) { int k = i * 8 + r; float v = jb.src[(size_t)(jb.k0 + k) * jb.ldsrc + jb.srccol0 + c]; if (jb.g) v *= jb.g[jb.k0 + k]; tile[k * 65 + c] = v; } }
    __syncthreads();
    { int n = tid >> 3, kq = tid & 7; u32x4 w;
      w[0] = pack2(tile[(kq * 8 + 0) * 65 + n], tile[(kq * 8 + 1) * 65 + n]); w[1] = pack2(tile[(kq * 8 + 2) * 65 + n], tile[(kq * 8 + 3) * 65 + n]);
      w[2] = pack2(tile[(kq * 8 + 4) * 65 + n], tile[(kq * 8 + 5) * 65 + n]); w[3] = pack2(tile[(kq * 8 + 6) * 65 + n], tile[(kq * 8 + 7) * 65 + n]);
      *(u32x4*)(jb.dst + (size_t)(jb.dstrow0 + n) * jb.lddst + jb.k0 + kq * 8) = w; }
    __syncthreads();
  }
  bft* xb = (bft*)(p.ws + OFF_A); float* r0 = (float*)(p.ws + OFF_R0);
  for (int it = blockIdx.x; it < T / 8; it += gridDim.x) {
    int tok = it * 8 + wid; const float* xr = xrow(p, tok); float ss = 0;
    for (int i = 0; i < 4; ++i) { f32x4 v = *(const f32x4*)(xr + i * 256 + lane * 4); ss += v[0] * v[0] + v[1] * v[1] + v[2] * v[2] + v[3] * v[3];
      u32x2 w = {pack2(v[0], v[1]), pack2(v[2], v[3])}; *(u32x2*)(xb + (size_t)tok * LDP + i * 256 + lane * 4) = w; }
    ss = wave_sum(ss); if (lane == 0) r0[tok] = rsqrtf(ss * (1.f / 1024) + EPS);
  }
  const long gsz = (long)gridDim.x * NTHR, gid = (long)blockIdx.x * NTHR + tid;
  { float* z = (float*)(p.ws + OFF_SSQ1); for (long i = gid; i < 2 * T; i += gsz) z[i] = 0.f; }
  { float* rt = (float*)(p.ws + OFF_ROPE); for (long i = gid; i < 8192 * 32; i += gsz) { int pos = (int)(i >> 5), k = (int)(i & 31); float s, c; sincos_d((double)pos * p.rope_inv[k], s, c); rt[pos * 64 + k] = c; rt[pos * 64 + 32 + k] = s; } }
  { float* h2t = (float*)(p.ws + OFF_H2);
    for (int it = blockIdx.x * 8 + wid; it < (8192 + 4096) * 2 / 4; it += gridDim.x * 8) {
      const int i4 = it * 4; int Lsel = i4 < 16384 ? 0 : 1; int r = Lsel ? i4 - 16384 : i4; int L = Lsel ? 4096 : 8192; int dir = r / L, l0 = r % L;
      float zv[4];
#pragma unroll
      for (int k = 0; k < 4; ++k) { const int l = l0 + k; float tl = (float)l / (float)(L - 1); double w = 6.283185307179586 * (double)l / (double)L; float z = 0.f;
        if (lane == 0) z = tl;
        else if (lane <= 32) { int jj = (lane - 1) & 15; double band = 1e-4 + (double)jj * ((15.0 - 1e-4) / 15.0); float s, c; sincos_d(band * w, s, c); z = lane <= 16 ? c : -s; }
        zv[k] = z; }
      const float* w1 = p.hy_f_w1 + (size_t)dir * 33 * 64; const float b1v = p.hy_f_b1[dir * 64 + lane]; float a[4] = {b1v, b1v, b1v, b1v};
      for (int i = 0; i < 33; ++i) { const float wv = w1[i * 64 + lane];
#pragma unroll
        for (int k = 0; k < 4; ++k) a[k] += __shfl(zv[k], i) * wv; }
      const float f1 = p.hy_f_freq1[dir * 64 + lane]; float h1[4];
#pragma unroll
      for (int k = 0; k < 4; ++k) h1[k] = sin_f(f1 * a[k]);
      const float* w2 = p.hy_f_w2 + (size_t)dir * 64 * 64; const float b2v = p.hy_f_b2[dir * 64 + lane]; float bb[4] = {b2v, b2v, b2v, b2v};
      for (int i = 0; i < 64; ++i) { const float wv = w2[i * 64 + lane];
#pragma unroll
        for (int k = 0; k < 4; ++k) bb[k] += __shfl(h1[k], i) * wv; }
      const float f2 = p.hy_f_freq2[dir * 64 + lane]; f32x4 o;
#pragma unroll
      for (int k = 0; k < 4; ++k) o[k] = sin_f(f2 * bb[k]);
      size_t base = Lsel ? (size_t)8192 * 2 * 64 : 0; *(f32x4*)(h2t + base + ((size_t)dir * 64 + lane) * L + l0) = o;
    } }
}

struct APlain { const bft* A; int lda; int brow; DI const bft* operator()(int row, int kt, int ch) const { return A + (size_t)(brow + row) * lda + kt * 64 + ch * 8; } };
template <class AF>
DI void gemm_stage(int tid, const AF& af, const bft* Bt, int ldb, int bcol, int kt, char* sA, char* sB) {
#pragma unroll
  for (int i = 0; i < 4; ++i) { int slot = tid + i * 512, row = slot >> 3, ch = (slot & 7) ^ (row & 7);
    __builtin_amdgcn_global_load_lds((const unsigned*)af(row, kt, ch), (unsigned*)(sA + slot * 16), 16, 0, 0); }
#pragma unroll
  for (int i = 0; i < 2; ++i) { int slot = tid + i * 512, row = slot >> 3, ch = (slot & 7) ^ (row & 7);
    __builtin_amdgcn_global_load_lds((const unsigned*)(Bt + (size_t)(bcol + row) * ldb + kt * 64 + ch * 8), (unsigned*)(sB + slot * 16), 16, 0, 0); }
}
DI void gemm_compute(int tid, const char* sA, const char* sB, f32x4 (&acc)[4][4]) {
  const int wid = tid >> 6, lane = tid & 63, wr = wid >> 1, wc = wid & 1, fr = lane & 15, fq = lane >> 4;
#pragma unroll
  for (int kk = 0; kk < 2; ++kk) {
    bf16x8 a[4], b[4];
#pragma unroll
    for (int m = 0; m < 4; ++m) { int row = wr * 64 + m * 16 + fr; a[m] = *(const bf16x8*)(sA + row * 128 + (((kk * 4 + fq) ^ (row & 7)) << 4)); }
#pragma unroll
    for (int n = 0; n < 4; ++n) { int row = wc * 64 + n * 16 + fr; b[n] = *(const bf16x8*)(sB + row * 128 + (((kk * 4 + fq) ^ (row & 7)) << 4)); }
#pragma unroll
    for (int m = 0; m < 4; ++m)
#pragma unroll
      for (int n = 0; n < 4; ++n) acc[m][n] = __builtin_amdgcn_mfma_f32_16x16x32_bf16(a[m], b[n], acc[m][n], 0, 0, 0);
  }
}
template <class AF>
DI void gemm_mainloop_t(int tid, const AF& af, const bft* Bt, int ldb, int bcol, int K, f32x4 (&acc)[4][4]) {
  const int nk = K >> 6;
  gemm_stage(tid, af, Bt, ldb, bcol, 0, smem, smem + 32768);
  if (nk > 1) gemm_stage(tid, af, Bt, ldb, bcol, 1, smem + 49152, smem + 49152 + 32768);
  int cb = 0;
#pragma unroll 1
  for (int kt = 0; kt < nk; ++kt) {
    if (kt + 1 < nk) asm volatile("s_waitcnt vmcnt(6)" ::: "memory"); else asm volatile("s_waitcnt vmcnt(0)" ::: "memory");
    __syncthreads();
    if (kt + 2 < nk) { int nb = cb + 2; if (nb >= 3) nb -= 3; char* nxt = smem + nb * 49152; gemm_stage(tid, af, Bt, ldb, bcol, kt + 2, nxt, nxt + 32768); }
    char* cur = smem + cb * 49152;
    gemm_compute(tid, cur, cur + 32768, acc);
    if (++cb == 3) cb = 0;
  }
  __syncthreads();
}
DI void gemm_mainloop(int tid, const bft* A, int lda, const bft* Bt, int ldb, int brow, int bcol, int K, f32x4 (&acc)[4][4]) {
  APlain af{A, lda, brow}; gemm_mainloop_t(tid, af, Bt, ldb, bcol, K, acc);
}
template <class AF>
DI void g256_stage(int tid, const AF& af, const bft* Bt, int ldb, int bcol, int kt, char* sA, char* sB) {
#pragma unroll
  for (int i = 0; i < 4; ++i) { int slot = tid + i * 512, row = slot >> 3, ch = (slot & 7) ^ (row & 7);
    __builtin_amdgcn_global_load_lds((const unsigned*)af(row, kt, ch), (unsigned*)(sA + slot * 16), 16, 0, 0); }
#pragma unroll
  for (int i = 0; i < 4; ++i) { int slot = tid + i * 512, row = slot >> 3, ch = (slot & 7) ^ (row & 7);
    __builtin_amdgcn_global_load_lds((const unsigned*)(Bt + (size_t)(bcol + row) * ldb + kt * 64 + ch * 8), (unsigned*)(sB + slot * 16), 16, 0, 0); }
}
template <int KK0, int KK1>
DI void g256_compute(int tid, const char* sA, const char* sB, f32x4 (&acc)[8][4]) {
  const int wid = tid >> 6, lane = tid & 63, wr = wid >> 2, wc = wid & 3, fr = lane & 15, fq = lane >> 4;
#pragma unroll
  for (int kk = KK0; kk < KK1; ++kk) {
    bf16x8 b[4], a[4], a2[4];
#pragma unroll
    for (int n = 0; n < 4; ++n) { int row = wc * 64 + n * 16 + fr; b[n] = *(const bf16x8*)(sB + row * 128 + (((kk * 4 + fq) ^ (row & 7)) << 4)); }
#pragma unroll
    for (int m = 0; m < 4; ++m) { int row = wr * 128 + m * 16 + fr; a[m] = *(const bf16x8*)(sA + row * 128 + (((kk * 4 + fq) ^ (row & 7)) << 4)); }
    __builtin_amdgcn_sched_barrier(0);
#pragma unroll
    for (int m = 0; m < 4; ++m) { int row = wr * 128 + (4 + m) * 16 + fr; a2[m] = *(const bf16x8*)(sA + row * 128 + (((kk * 4 + fq) ^ (row & 7)) << 4)); }
    __builtin_amdgcn_s_setprio(1);
#pragma unroll
    for (int m = 0; m < 4; ++m)
#pragma unroll
      for (int n = 0; n < 4; ++n) acc[m][n] = __builtin_amdgcn_mfma_f32_16x16x32_bf16(a[m], b[n], acc[m][n], 0, 0, 0);
    __builtin_amdgcn_sched_barrier(0);
#pragma unroll
    for (int m = 0; m < 4; ++m)
#pragma unroll
      for (int n = 0; n < 4; ++n) acc[4 + m][n] = __builtin_amdgcn_mfma_f32_16x16x32_bf16(a2[m], b[n], acc[4 + m][n], 0, 0, 0);
    __builtin_amdgcn_s_setprio(0);
    __builtin_amdgcn_sched_barrier(0);
  }
}
template <class AF>
DI void g256_mainloop_t(int tid, const AF& af, const bft* Bt, int ldb, int bcol, int K, f32x4 (&acc)[8][4]) {
  const int nk = K >> 6;
  g256_stage(tid, af, Bt, ldb, bcol, 0, smem, smem + 32768);
#pragma unroll 1
  for (int kt = 0; kt < nk; ++kt) {
    asm volatile("s_waitcnt vmcnt(0)" ::: "memory");
    __syncthreads();
    char* cur = smem + (kt & 1) * 65536; char* nxt = smem + ((kt + 1) & 1) * 65536;
    if (tid < 256) {
      if (kt + 1 < nk) g256_stage(tid, af, Bt, ldb, bcol, kt + 1, nxt, nxt + 32768);
      g256_compute<0, 2>(tid, cur, cur + 32768, acc);
    } else {
      g256_compute<0, 1>(tid, cur, cur + 32768, acc);
      if (kt + 1 < nk) g256_stage(tid, af, Bt, ldb, bcol, kt + 1, nxt, nxt + 32768);
      g256_compute<1, 2>(tid, cur, cur + 32768, acc);
    }
  }
  __syncthreads();
}
DI void g256_mainloop(int tid, const bft* A, int lda, const bft* Bt, int ldb, int brow, int bcol, int K, f32x4 (&acc)[8][4]) {
  APlain af{A, lda, brow}; g256_mainloop_t(tid, af, Bt, ldb, bcol, K, acc);
}
#define ACC256_ZERO(acc) for (int m_ = 0; m_ < 8; ++m_) for (int n_ = 0; n_ < 4; ++n_) acc[m_][n_] = f32x4{0.f, 0.f, 0.f, 0.f}
#define ACC_ZERO(acc) for (int m_ = 0; m_ < 4; ++m_) for (int n_ = 0; n_ < 4; ++n_) acc[m_][n_] = f32x4{0.f, 0.f, 0.f, 0.f}
template <int PATCH = 98304> DI void epi_stage(int tid, const f32x4 (&am)[4], float (&v)[16]) {
  const int lane = tid & 63, wid = tid >> 6, fr = lane & 15, fq = lane >> 4;
  float* stg = (float*)(smem + PATCH) + wid * (16 * 68);
  asm volatile("" ::: "memory");
#pragma unroll
  for (int n = 0; n < 4; ++n)
#pragma unroll
    for (int j = 0; j < 4; ++j) stg[(fq * 4 + j) * 68 + n * 16 + fr] = am[n][j];
  asm volatile("s_waitcnt lgkmcnt(0)" ::: "memory");
  const float* rp = stg + (lane >> 2) * 68 + (lane & 3) * 16;
#pragma unroll
  for (int i = 0; i < 4; ++i) { f32x4 t = *(const f32x4*)(rp + i * 4); v[4 * i] = t[0]; v[4 * i + 1] = t[1]; v[4 * i + 2] = t[2]; v[4 * i + 3] = t[3]; }
  asm volatile("" ::: "memory");
}
DI void store16_bf(bft* dst, const float (&v)[16]) {
  u32x4 o0 = {pack2(v[0], v[1]), pack2(v[2], v[3]), pack2(v[4], v[5]), pack2(v[6], v[7])}, o1 = {pack2(v[8], v[9]), pack2(v[10], v[11]), pack2(v[12], v[13]), pack2(v[14], v[15])};
  *(u32x4*)dst = o0; *(u32x4*)(dst + 8) = o1;
}
DI void load16_bf(const bft* src, float (&v)[16]) {
  u32x4 w0 = *(const u32x4*)src, w1 = *(const u32x4*)(src + 8);
#pragma unroll
  for (int i = 0; i < 4; ++i) { v[2 * i] = __uint_as_float(w0[i] << 16); v[2 * i + 1] = __uint_as_float(w0[i] & 0xffff0000u); v[8 + 2 * i] = __uint_as_float(w1[i] << 16); v[8 + 2 * i + 1] = __uint_as_float(w1[i] & 0xffff0000u); }
}
DI void load16_f(const float* src, float (&v)[16]) {
#pragma unroll
  for (int i = 0; i < 4; ++i) { f32x4 t = *(const f32x4*)(src + 4 * i); v[4 * i] = t[0]; v[4 * i + 1] = t[1]; v[4 * i + 2] = t[2]; v[4 * i + 3] = t[3]; }
}
DI void store16_f(float* dst, const float (&v)[16]) {
#pragma unroll
  for (int i = 0; i < 4; ++i) { f32x4 t = {v[4 * i], v[4 * i + 1], v[4 * i + 2], v[4 * i + 3]}; *(f32x4*)(dst + 4 * i) = t; }
}
#define EPI_BEGIN const int wid = tid >> 6, lane = tid & 63, wr = wid >> 1, wc = wid & 1; \
  _Pragma("unroll") for (int m = 0; m < 4; ++m) { float v[16]; epi_stage(tid, acc[m], v); const int row = brow + wr * 64 + m * 16 + (lane >> 2), col = bcol + wc * 64 + (lane & 3) * 16; (void)row; (void)col;
#define EPI_END }
#define EPI256_BEGIN const int wid = tid >> 6, lane = tid & 63, wr = wid >> 2, wc = wid & 3; \
  _Pragma("unroll") for (int m = 0; m < 8; ++m) { float v[16]; epi_stage<65536>(tid, acc[m], v); const int row = brow + wr * 128 + m * 16 + (lane >> 2), col = bcol + wc * 64 + (lane & 3) * 16; (void)row; (void)col;

DI void phase_inproj0(const Params& p) {
  int tix_ = threadIdx.x; asm volatile("" : "+v"(tix_));
  const bft* A = (const bft*)(p.ws + OFF_A); const bft* Bt = (const bft*)(p.ws + OFF_W0t); const float* r0 = (const float*)(p.ws + OFF_R0);
  bft* u = (bft*)(p.ws + OFF_U); bft* lat = (bft*)(p.ws + OFF_LAT); bft* G0 = (bft*)(p.ws + OFF_G0);
  const int NT = 15, MT = T / 256;
  for (int r_ = 0, it; xcd_item(r_, NT, MT, it); ++r_) {
    int brow = (it / NT) * 256, bcol = (it % NT) * 256;
    int tid = tix_; asm volatile("" : "+v"(tid));
    f32x4 acc[8][4]; ACC256_ZERO(acc);
    g256_mainloop(tid, A, LDP, Bt, LDW1, brow, bcol, 1024, acc);
    EPI256_BEGIN
      float rs = r0[row];
#pragma unroll
      for (int i = 0; i < 16; ++i) v[i] *= rs;
      if (col < 1024) store16_bf(u + (size_t)row * 1024 + col, v);
      else if (col < 1728) store16_bf(lat + (size_t)row * 704 + col - 1024, v);
      else if (col < 3776) {
#pragma unroll
        for (int i = 0; i < 16; ++i) v[i] = siluf(v[i]);
        store16_bf(G0 + (size_t)row * 2048 + col - 1728, v); }
    EPI_END
  }
}

DI void phase_mlaprep(const Params& p) {
  int tix_ = threadIdx.x; asm volatile("" : "+v"(tix_));
  const int lane = tix_ & 63, wid = tix_ >> 6;
  bft* lat = (bft*)(p.ws + OFF_LAT); const float* rt = (const float*)(p.ws + OFF_ROPE);
  for (int it = blockIdx.x; it < T / 8; it += gridDim.x) {
    int tok = it * 8 + wid; bft* r = lat + (size_t)tok * 704;
    float q[6], kv[4], ss = 0, ss2 = 0;
    for (int i = 0; i < 6; ++i) { q[i] = bf2f(r[lane + 64 * i]); ss += q[i] * q[i]; }
    for (int i = 0; i < 4; ++i) { kv[i] = bf2f(r[384 + lane + 64 * i]); ss2 += kv[i] * kv[i]; }
    float kr = bf2f(r[640 + lane]);
    ss = wave_sum(ss); ss2 = wave_sum(ss2);
    float rq = rsqrtf(ss * (1.f / 384) + EPS), rkv = rsqrtf(ss2 * (1.f / 256) + EPS);
    for (int i = 0; i < 6; ++i) r[lane + 64 * i] = f2bf(q[i] * rq);
    for (int i = 0; i < 4; ++i) r[384 + lane + 64 * i] = f2bf(kv[i] * rkv);
    int pos = tok_pos(tok); float c = rt[pos * 64 + (lane & 31)], s = rt[pos * 64 + 32 + (lane & 31)];
    float xo = __shfl_xor(kr, 32);
    float o = lane < 32 ? kr * c - xo * s : xo * s + kr * c;
    r[640 + lane] = f2bf(o);
  }
}

constexpr int S5Q = 32, S5NC = T / S5Q;
constexpr size_t S5_OFF_S = 0, S5_OFF_X = (size_t)64 * S5NC * 256 * 4, S5_OFF_TM = S5_OFF_X + (size_t)64 * S5NC * 256 * 2;
DI void s5_lam(const Params& p, int dir, int g, int m, float tau, float& pr, float& pi) {
  int idx = (dir * 64 + g) * 64 + m; float are = p.s5_a_re[idx], aim = p.s5_a_im[idx], dt = __expf(p.s5_log_dt[dir * 64 + g]);
  float mag = __expf(are * dt * tau), s, c; sincos_d((double)aim * (double)dt * (double)tau, s, c); pr = mag * c; pi = mag * s;
}
DI void phase_s5gen(const Params& p) {
  int tix_ = threadIdx.x; asm volatile("" : "+v"(tix_));
  const int tid = tix_;
  float2* pw = (float2*)smem;
  float2* Bb = (float2*)(smem + 33792);
  float2* Cc = (float2*)(smem + 33792 + 16384);
  float* Kt = (float*)(smem + 33792 + 32768);
  bft* Tm = (bft*)((char*)p.out + S5_OFF_TM); bft* W1 = (bft*)(p.ws + OFF_A);
  for (int it = blockIdx.x; it < 256; it += gridDim.x) {
    const int g = it >> 2, q4 = it & 3;
    if (tid < 128) { int d = tid >> 6, m = tid & 63; int idx = (d * 64 + g) * 64 + m;
      float are = p.s5_a_re[idx], aim = p.s5_a_im[idx];
      for (int tau = 0; tau <= 32; ++tau) { float pr, pi; s5_lam(p, d, g, m, (float)tau, pr, pi); pw[(d * 33 + tau) * 64 + m] = float2{pr, pi}; }
      float abr, abi; s5_lam(p, d, g, m, 1.f, abr, abi);
      float den = are * are + aim * aim, cr = ((abr - 1.f) * are + abi * aim) / den, ci = (abi * are - (abr - 1.f) * aim) / den;
      for (int c = 0; c < 16; ++c) { float br = p.s5_b_re[(size_t)idx * 16 + c], bi = p.s5_b_im[(size_t)idx * 16 + c]; Bb[(d * 64 + m) * 16 + c] = float2{cr * br - ci * bi, cr * bi + ci * br};
        Cc[(d * 16 + c) * 64 + m] = float2{p.s5_c_re[((size_t)(d * 64 + g) * 16 + c) * 64 + m], p.s5_c_im[((size_t)(d * 64 + g) * 16 + c) * 64 + m]}; } }
    __syncthreads();
    for (int e = tid; e < 1024; e += NTHR) {
      const int d = e >> 9, tau = (e >> 4) & 31, cb = ((e >> 2) & 3) * 4, c2b = (e & 3) * 4; float acc[4][4];
#pragma unroll
      for (int i = 0; i < 4; ++i)
#pragma unroll
        for (int j = 0; j < 4; ++j) acc[i][j] = 0.f;
      for (int m = 0; m < 64; ++m) { const float2 pwv = pw[(d * 33 + tau) * 64 + m]; float2 P[4], B[4];
#pragma unroll
        for (int i = 0; i < 4; ++i) { P[i] = cmul(Cc[(d * 16 + cb + i) * 64 + m], pwv); B[i] = Bb[(d * 64 + m) * 16 + c2b + i]; }
#pragma unroll
        for (int i = 0; i < 4; ++i)
#pragma unroll
          for (int j = 0; j < 4; ++j) acc[i][j] += P[i].x * B[j].x - P[i].y * B[j].y; }
#pragma unroll
      for (int i = 0; i < 4; ++i)
#pragma unroll
        for (int j = 0; j < 4; ++j) Kt[((d * 32 + tau) * 16 + cb + i) * 16 + c2b + j] = acc[i][j]; }
    __syncthreads();
    for (int e = tid; e < 128 * 96; e += NTHR) { int n = q4 * 128 + e / 96, k8 = e % 96; int to = n >> 4, c = n & 15; float v[8];
      if (k8 < 64) { int ti = k8 >> 1, c0 = (k8 & 1) * 8;
#pragma unroll
        for (int j = 0; j < 8; ++j) { int c2 = c0 + j; float x;
          if (to > ti) x = Kt[((0 * 32 + (to - ti)) * 16 + c) * 16 + c2]; else if (to < ti) x = Kt[((1 * 32 + (ti - to)) * 16 + c) * 16 + c2];
          else { x = Kt[(c) * 16 + c2] + Kt[((32) * 16 + c) * 16 + c2]; if (c == c2) x += p.s5_d[g * 16 + c]; }
          v[j] = x; } }
      else {
#pragma unroll
        for (int j = 0; j < 8; ++j) { int kk = k8 * 8 - 512 + j; int d = kk >> 7, ri = (kk >> 6) & 1, m = kk & 63; int pwr = d == 0 ? to + 1 : 32 - to;
          float2 P = cmul(Cc[(d * 16 + c) * 64 + m], pw[(d * 33 + pwr) * 64 + m]); v[j] = ri == 0 ? P.x : -P.y; } }
      u32x4 w = {pack2(v[0], v[1]), pack2(v[2], v[3]), pack2(v[4], v[5]), pack2(v[6], v[7])};
      *(u32x4*)(Tm + ((size_t)g * 512 + n) * 768 + k8 * 8) = w; }
    for (int e = tid; e < 64 * 64; e += NTHR) { int n = q4 * 64 + (e >> 6), k8 = e & 63; int d = n >> 7, ri = (n >> 6) & 1, m = n & 63; float v[8];
#pragma unroll
      for (int j = 0; j < 8; ++j) { int k = k8 * 8 + j, tau = k >> 4, c2 = k & 15; int pwr = d == 0 ? 31 - tau : tau;
        float2 V = cmul(pw[(d * 33 + pwr) * 64 + m], Bb[(d * 64 + m) * 16 + c2]); v[j] = ri == 0 ? V.x : V.y; }
      u32x4 w = {pack2(v[0], v[1]), pack2(v[2], v[3]), pack2(v[4], v[5]), pack2(v[6], v[7])};
      *(u32x4*)(W1 + ((size_t)g * 256 + n) * 512 + k8 * 8) = w; }
    __syncthreads();
  }
}
struct AS5 { const bft* u; const bft* X; int g, mrow0; bool withX;
  DI const bft* operator()(int row, int kt, int ch) const {
    if (kt < 8) return u + ((size_t)((mrow0 + row) * 32 + kt * 4 + (ch >> 1)) * 1024 + g * 16 + (ch & 1) * 8);
    return X + ((size_t)(g * S5NC + mrow0 + row) * 256 + (kt - 8) * 64 + ch * 8); } };
DI void phase_s5step1(const Params& p) {
  int tix_ = threadIdx.x; asm volatile("" : "+v"(tix_));
  const bft* u = (const bft*)(p.ws + OFF_U); const bft* W1 = (const bft*)(p.ws + OFF_A); float* S = (float*)((char*)p.out + S5_OFF_S);
  for (int r_ = 0, it; xcd_item(r_, 6, 64, it); ++r_) {
    int g = it / 6, mt = it % 6; const int brow = mt * 256, bcol = 0;
    int tid = tix_; asm volatile("" : "+v"(tid));
    f32x4 acc[8][4]; ACC256_ZERO(acc);
    AS5 af{u, nullptr, g, brow, false};
    g256_mainloop_t(tid, af, W1 + (size_t)g * 256 * 512, 512, bcol, 512, acc);
    EPI256_BEGIN
      store16_f(S + ((size_t)g * S5NC + row) * 256 + col, v);
    EPI_END
  }
}
DI void phase_s5scan(const Params& p) {
  int tix_ = threadIdx.x; asm volatile("" : "+v"(tix_));
  const int lane = tix_ & 63, wid = tix_ >> 6;
  const float* S = (const float*)((char*)p.out + S5_OFF_S); bft* X = (bft*)((char*)p.out + S5_OFF_X);
  for (int wi = blockIdx.x * 8 + wid; wi < 1280; wi += gridDim.x * 8) {
    int dir = wi & 1, g = (wi >> 1) & 63, s = wi >> 7;
    int L = s < 2 ? 8192 : 4096; int tok0 = s < 2 ? s * 8192 : TP + (s - 2) * 4096; int nch = L / S5Q, kc0 = tok0 / S5Q;
    float aqr, aqi; s5_lam(p, dir, g, lane, (float)S5Q, aqr, aqi);
    float xr = 0.f, xi = 0.f;
    for (int kb = 0; kb < nch; kb += 8) {
      float sr[8], si[8];
#pragma unroll
      for (int i = 0; i < 8; ++i) { int k = dir ? nch - 1 - (kb + i) : kb + i; const float* sp = S + ((size_t)g * S5NC + kc0 + k) * 256 + dir * 128 + lane; sr[i] = sp[0]; si[i] = sp[64]; }
#pragma unroll
      for (int i = 0; i < 8; ++i) { int k = dir ? nch - 1 - (kb + i) : kb + i; bft* xp = X + ((size_t)g * S5NC + kc0 + k) * 256 + dir * 128 + lane;
        xp[0] = f2bf(xr); xp[64] = f2bf(xi);
        float nr = aqr * xr - aqi * xi + sr[i], ni = aqr * xi + aqi * xr + si[i]; xr = nr; xi = ni; }
    }
  }
}
DI void phase_s5step3(const Params& p) {
  int tix_ = threadIdx.x; asm volatile("" : "+v"(tix_));
  const bft* u = (const bft*)(p.ws + OFF_U); const bft* X = (const bft*)((char*)p.out + S5_OFF_X); const bft* Tm = (const bft*)((char*)p.out + S5_OFF_TM);
  bft* ys = (bft*)(p.ws + OFF_A);
  for (int r_ = 0, it; xcd_item(r_, 12, 64, it); ++r_) {
    int g = it / 12, r = it % 12, mt = r >> 1, nt = r & 1; const int brow = mt * 256, bcol = nt * 256;
    int tid = tix_; asm volatile("" : "+v"(tid));
    f32x4 acc[8][4]; ACC256_ZERO(acc);
    AS5 af{u, X, g, brow, true};
    g256_mainloop_t(tid, af, Tm + (size_t)g * 512 * 768, 768, bcol, 768, acc);
    EPI256_BEGIN
#pragma unroll
      for (int i = 0; i < 16; ++i) v[i] = geluf(v[i]);
      store16_bf(ys + ((size_t)row * 32 + (col >> 4)) * LDP + g * 16, v);
    EPI_END
  }
}

DI void phase_upproj(const Params& p, int sg) {
  int tix_ = threadIdx.x; asm volatile("" : "+v"(tix_));
  const bft* lat = (const bft*)(p.ws + OFF_LAT) + (size_t)sg * 16384 * 704;
  bft* Q = (bft*)p.out; bft* Kb = Q + (size_t)16384 * 1536; bft* Vb = Kb + (size_t)16384 * 1536;
  const float* rt = (const float*)(p.ws + OFF_ROPE);
  const int MT = 64, NQ = 6, NKV = 8;
  for (int r_ = 0, it; xcd_item(r_, NQ + NKV, MT, it); ++r_) {
    const int mt_ = it / (NQ + NKV), nr_ = it % (NQ + NKV);
    int tid = tix_; asm volatile("" : "+v"(tid));
    f32x4 acc[8][4]; ACC256_ZERO(acc);
    if (nr_ < NQ) {
      int brow = mt_ * 256, bcol = nr_ * 256;
      g256_mainloop(tid, lat, 704, (const bft*)(p.ws + OFF_Wq), LDWQ, brow, bcol, 384, acc);
      EPI256_BEGIN
        const int cw = bcol + wc * 64; const bool is_rope = (cw % 192) == 128;
        if (is_rope) { int pos = tok_pos(sg * 16384 + row); const int cg = lane & 3; const float* rp = rt + pos * 64 + (cg & 1) * 16;
#pragma unroll
          for (int i = 0; i < 16; ++i) { float c = rp[i], s = rp[32 + i]; float xo = __shfl_xor(v[i], 2); v[i] = cg < 2 ? v[i] * c - xo * s : xo * s + v[i] * c; } }
        store16_bf(Q + (size_t)row * 1536 + col, v);
      EPI_END
    } else {
      int brow = mt_ * 256, nt = nr_ - NQ, bcol = nt * 256;
      g256_mainloop(tid, lat + 384, 704, (const bft*)(p.ws + OFF_Wkv), LDWS, brow, bcol, 256, acc);
      const int h = nt;
      EPI256_BEGIN
        const int d = col - bcol;
        if (d >= 128) store16_bf(Vb + (size_t)row * 1024 + h * 128 + d - 128, v); else store16_bf(Kb + (size_t)row * 1536 + h * 192 + d, v);
      EPI_END
      { for (int i = tix_; i < 256 * 8; i += 512) { int r = i >> 3, c8 = i & 7;
          *(u32x4*)(Kb + (size_t)(brow + r) * 1536 + h * 192 + 128 + c8 * 8) = *(const u32x4*)(lat + (size_t)(brow + r) * 704 + 640 + c8 * 8); } }
    }
  }
}

constexpr int KVBLK = 64;
constexpr float ATT_SCALE = 0.07216878364870323f;
constexpr float ATT_THR = 8.f;
constexpr int SHM_V = KVBLK * 128 * 2, SHM_K = KVBLK * 400;
#define KSWZ(row, colB) ((row) * 400 + (colB))
#define SBAR() __builtin_amdgcn_sched_barrier(0)
DI int crow(int r, int hi) { return (r & 3) + 8 * (r >> 2) + 4 * hi; }
DI unsigned cvtpk(float lo, float hi) { unsigned r; asm volatile("v_cvt_pk_bf16_f32 %0, %1, %2" : "=v"(r) : "v"(lo), "v"(hi)); return r; }
DI void partialSM(f32x16& p0, f32x16& p1, float& m_reg, float& mn, float& alpha) {
  constexpr float C = ATT_SCALE * 1.4426950408889634f;
  float pmax = p0[0];
#pragma unroll
  for (int r = 1; r < 16; ++r) pmax = fmaxf(pmax, p0[r]);
#pragma unroll
  for (int r = 0; r < 16; ++r) pmax = fmaxf(pmax, p1[r]);
  { auto rr = __builtin_amdgcn_permlane32_swap(__float_as_uint(pmax), __float_as_uint(pmax), false, false);
    pmax = fmaxf(__uint_as_float(rr[0]), __uint_as_float(rr[1])); }
  if (__builtin_expect(__all(pmax - m_reg <= ATT_THR / ATT_SCALE), 1)) { mn = m_reg; alpha = 1.f; }
  else { mn = fmaxf(m_reg, pmax); alpha = __builtin_amdgcn_exp2f((m_reg - mn) * C); m_reg = mn; }
  float mnC = -mn * C;
#pragma unroll
  for (int r = 0; r < 16; ++r) p0[r] = fmaf(p0[r], C, mnC);
#pragma unroll
  for (int r = 0; r < 16; ++r) p1[r] = fmaf(p1[r], C, mnC);
#pragma unroll
  for (int r = 0; r < 16; ++r) p0[r] = __builtin_amdgcn_exp2f(p0[r]);
}
DI void finishSM(f32x16& p0, f32x16& p1, float alpha, float& l_reg, bf16x8& pa0, bf16x8& pa1, bf16x8& pa2, bf16x8& pa3) {
#pragma unroll
  for (int r = 0; r < 16; ++r) p1[r] = __builtin_amdgcn_exp2f(p1[r]);
  float ps = 0;
#pragma unroll
  for (int r = 0; r < 16; ++r) ps += p0[r];
#pragma unroll
  for (int r = 0; r < 16; ++r) ps += p1[r];
  { auto rr = __builtin_amdgcn_permlane32_swap(__float_as_uint(ps), __float_as_uint(ps), false, false);
    ps = __uint_as_float(rr[0]) + __uint_as_float(rr[1]); }
  l_reg = l_reg * alpha + ps;
#define PK4(P, BASE, OUT) do { unsigned a0 = cvtpk(P[BASE + 0], P[BASE + 1]), a1 = cvtpk(P[BASE + 2], P[BASE + 3]);   \
    unsigned b0 = cvtpk(P[BASE + 4], P[BASE + 5]), b1 = cvtpk(P[BASE + 6], P[BASE + 7]);                              \
    auto r0 = __builtin_amdgcn_permlane32_swap(a0, b0, false, false); auto r1 = __builtin_amdgcn_permlane32_swap(a1, b1, false, false); \
    u32x4 w = {r0[0], r1[0], r0[1], r1[1]}; OUT = *reinterpret_cast<bf16x8*>(&w); } while (0)
  PK4(p0, 0, pa0); PK4(p0, 8, pa1); PK4(p1, 0, pa2); PK4(p1, 8, pa3);
#undef PK4
}
DI void qkt(f32x16& p0, f32x16& p1, const char* Ks, const bf16x8* qr, int r32, int hi) {
  p0 = f32x16{}; p1 = f32x16{};
#pragma unroll
  for (int d0 = 0; d0 < 12; ++d0) { int cb = (d0 * 16 + hi * 8) * 2;
    bf16x8 b0 = *reinterpret_cast<const bf16x8*>(Ks + KSWZ(r32, cb));
    bf16x8 b1 = *reinterpret_cast<const bf16x8*>(Ks + KSWZ(32 + r32, cb));
    p0 = __builtin_amdgcn_mfma_f32_32x32x16_bf16(b0, qr[d0], p0, 0, 0, 0);
    p1 = __builtin_amdgcn_mfma_f32_32x32x16_bf16(b1, qr[d0], p1, 0, 0, 0); }
}
DI int v_st(int k, int c) { const int kk = (k & ~0xC) | ((k & 4) << 1) | ((k & 8) >> 1); return ((kk >> 3) * 4 + (c >> 5)) * 512 + ((kk & 7) * 32 + (c & 31)) * 2; }
DI int v_rd_base(int lane) { return ((lane & 3) << 3) | (((lane >> 2) & 3) << 6) | (((lane >> 4) & 1) << 5) | (((lane >> 5) & 1) << 8); }
constexpr int v_rd_off(int d0, int ks, int half) { return d0 * 512 + ks * 4096 + half * 2048; }
template <int OFF> DI s16x4 tr_read(int vb) { s16x4 r; asm volatile("ds_read_b64_tr_b16 %0, %1 offset:%2" : "=&v"(r) : "v"(vb), "i"(OFF) : "memory"); return r; }
template <int D0> DI void pv_one(f32x16& od, int vb, bf16x8 pa0, bf16x8 pa1, bf16x8 pa2, bf16x8 pa3) {
  const s16x4 l0 = tr_read<v_rd_off(D0, 0, 0)>(vb), h0 = tr_read<v_rd_off(D0, 0, 1)>(vb), l1 = tr_read<v_rd_off(D0, 1, 0)>(vb), h1 = tr_read<v_rd_off(D0, 1, 1)>(vb);
  const s16x4 l2 = tr_read<v_rd_off(D0, 2, 0)>(vb), h2 = tr_read<v_rd_off(D0, 2, 1)>(vb), l3 = tr_read<v_rd_off(D0, 3, 0)>(vb), h3 = tr_read<v_rd_off(D0, 3, 1)>(vb);
  asm volatile("s_waitcnt lgkmcnt(0)" ::: "memory"); SBAR();
#define PK(L, H) (bf16x8){L[0], L[1], L[2], L[3], H[0], H[1], H[2], H[3]}
  od = __builtin_amdgcn_mfma_f32_32x32x16_bf16(pa0, PK(l0, h0), od, 0, 0, 0);
  od = __builtin_amdgcn_mfma_f32_32x32x16_bf16(pa1, PK(l1, h1), od, 0, 0, 0);
  od = __builtin_amdgcn_mfma_f32_32x32x16_bf16(pa2, PK(l2, h2), od, 0, 0, 0);
  od = __builtin_amdgcn_mfma_f32_32x32x16_bf16(pa3, PK(l3, h3), od, 0, 0, 0);
#undef PK
}
DI void pv_d0(f32x16* o, int vb, bf16x8 pa0, bf16x8 pa1, bf16x8 pa2, bf16x8 pa3) {
  pv_one<0>(o[0], vb, pa0, pa1, pa2, pa3); pv_one<1>(o[1], vb, pa0, pa1, pa2, pa3); pv_one<2>(o[2], vb, pa0, pa1, pa2, pa3); pv_one<3>(o[3], vb, pa0, pa1, pa2, pa3);
}
DI void attn_body(const bft* __restrict__ Qb, const bft* __restrict__ Kh, const bft* __restrict__ Vh, bft* __restrict__ Gb, int seq) {
  int tid = threadIdx.x; asm volatile("" : "+v"(tid));
  const int wid = tid >> 6, lane = tid & 63, r32 = lane & 31, hi = lane >> 5;
  char* V_lds = smem; char* K_lds = smem + 2 * SHM_V;
  float* wsl = (float*)(smem + 2 * SHM_V + 2 * SHM_K) + wid * 64; float* li_l = wsl; float* al_l = wsl + 32;
  float m_reg = -1e30f, l_reg = 0; f32x16 o[4] = {}; bf16x8 qr[12];
  const bft* Qw = Qb + (size_t)(wid * 32 + r32) * 1536 + hi * 8;
#pragma unroll
  for (int d0 = 0; d0 < 12; ++d0) qr[d0] = *(const bf16x8*)(Qw + d0 * 16);
  const int sr = tid >> 4, sc = (tid & 15) * 8, vst0 = v_st(sr, sc), vst1 = v_st(32 + sr, sc);
  const int kr0 = tid / 24, kc0 = (tid % 24) * 8, kr1 = (tid + 512) / 24, kc1 = ((tid + 512) % 24) * 8, kr2 = (tid + 1024) / 24, kc2 = ((tid + 1024) % 24) * 8;
  const int vb0 = (int)(uintptr_t)V_lds + v_rd_base(lane);
  bf16x8 vs0, vs1, ks0, ks1, ks2;
#define SLOAD(k0) do { vs0 = *(const bf16x8*)(&Vh[(size_t)((k0) + sr) * 1024 + sc]); vs1 = *(const bf16x8*)(&Vh[(size_t)((k0) + 32 + sr) * 1024 + sc]); \
    ks0 = *(const bf16x8*)(&Kh[(size_t)((k0) + kr0) * 1536 + kc0]); ks1 = *(const bf16x8*)(&Kh[(size_t)((k0) + kr1) * 1536 + kc1]); ks2 = *(const bf16x8*)(&Kh[(size_t)((k0) + kr2) * 1536 + kc2]); } while (0)
#define SWRITE(b) do { *(bf16x8*)(V_lds + (b) * SHM_V + vst0) = vs0; *(bf16x8*)(V_lds + (b) * SHM_V + vst1) = vs1; \
    *(bf16x8*)(K_lds + (b) * SHM_K + KSWZ(kr0, kc0 * 2)) = ks0; *(bf16x8*)(K_lds + (b) * SHM_K + KSWZ(kr1, kc1 * 2)) = ks1; *(bf16x8*)(K_lds + (b) * SHM_K + KSWZ(kr2, kc2 * 2)) = ks2; } while (0)
#define SWAIT() asm volatile("s_waitcnt vmcnt(0)" ::: "memory")
#define RESC(a) do { if (__any((a) < 1.f)) { if (hi == 0) al_l[r32] = (a); asm volatile("s_waitcnt lgkmcnt(0)" ::: "memory"); \
    for (int d = 0; d < 4; ++d) for (int r = 0; r < 16; ++r) o[d][r] *= al_l[crow(r, hi)]; } } while (0)
  f32x16 pA0, pA1; float mnA, alA; bf16x8 pa0, pa1, pa2, pa3; const int NT = seq / KVBLK;
  SLOAD(0); SWAIT(); SWRITE(0); __syncthreads();
  for (int j = 0; j < NT; ++j) {
    const int b = j & 1;
    if (j + 1 < NT) SLOAD((j + 1) * KVBLK);
    SBAR(); qkt(pA0, pA1, K_lds + b * SHM_K, qr, r32, hi);
    partialSM(pA0, pA1, m_reg, mnA, alA);
    RESC(alA);
    finishSM(pA0, pA1, alA, l_reg, pa0, pa1, pa2, pa3); SBAR();
    pv_d0(o, vb0 + b * SHM_V, pa0, pa1, pa2, pa3);
    if (j + 1 < NT) { SWAIT(); SWRITE(b ^ 1); }
    __syncthreads();
  }
  if (hi == 0) li_l[r32] = l_reg; asm volatile("s_waitcnt lgkmcnt(0)" ::: "memory");
  float rli[16];
#pragma unroll
  for (int r = 0; r < 16; ++r) rli[r] = __builtin_amdgcn_rcpf(li_l[crow(r, hi)]);
  bft* Gw = Gb + (size_t)(wid * 32) * 2048;
#pragma unroll
  for (int r = 0; r < 16; ++r) { int orow = crow(r, hi);
#pragma unroll
    for (int d0 = 0; d0 < 4; ++d0) { bft* gp = Gw + (size_t)orow * 2048 + d0 * 32 + r32; *gp = f2bf(o[d0][r] * rli[r] * bf2f(*gp)); } }
  __syncthreads();
#undef SLOAD
#undef SWRITE
#undef SWAIT
#undef RESC
}
DI void phase_attn(const Params& p, int sg) {
  int tix_ = threadIdx.x; asm volatile("" : "+v"(tix_));
  const bft* Q = (const bft*)p.out; const bft* Kb = Q + (size_t)16384 * 1536; const bft* Vb = Kb + (size_t)16384 * 1536;
  bft* G0 = (bft*)(p.ws + OFF_G0) + (size_t)sg * 16384 * 2048;
  const int L = sg == 0 ? 8192 : 4096; const int nqb = L / 256;
  for (int r_ = 0, it; xcd_item(r_, nqb, 512 / nqb, it); ++r_) {
    int qb = it % nqb, rest = it / nqb, h = rest & 7, sl = rest >> 3;
    size_t t0 = (size_t)sl * L;
    attn_body(Q + (t0 + qb * 256) * 1536 + h * 192, Kb + t0 * 1536 + h * 192, Vb + t0 * 1024 + h * 128, G0 + (t0 + qb * 256) * 2048 + 1024 + h * 128, L);
  }
}

DI void convert_p(const Params& p, int layer) {
  int tix_ = threadIdx.x; asm volatile("" : "+v"(tix_));
  bft* pb = (bft*)(p.ws + OFF_LAT);
  const long gsz = (long)gridDim.x * NTHR, gid = (long)blockIdx.x * NTHR + tix_;
  const float* pp = p.p_prompt + (size_t)layer * TP * 256; const float* ps = p.p_sample + (size_t)layer * (T - TP) * 256;
  for (long i = gid; i < (long)T * 256 / 4; i += gsz) { long e = i * 4; f32x4 v = e < (long)TP * 256 ? *(const f32x4*)(pp + e) : *(const f32x4*)(ps + (e - (long)TP * 256));
    u32x2 w = {pack2(v[0], v[1]), pack2(v[2], v[3])}; *(u32x2*)(pb + e) = w; }
}
DI void phase_glu(const Params& p) {
  int tix_ = threadIdx.x; asm volatile("" : "+v"(tix_));
  const bft* ys = (const bft*)(p.ws + OFF_A); bft* G0 = (bft*)(p.ws + OFF_G0);
  for (int r_ = 0, it; xcd_item(r_, 4, T / 256, it); ++r_) {
    int brow = (it >> 2) * 256, bcol = (it & 3) * 256;
    int tid = tix_; asm volatile("" : "+v"(tid));
    f32x4 acc[8][4]; ACC256_ZERO(acc);
    g256_mainloop(tid, ys, LDP, (const bft*)(p.ws + OFF_Wglu), LDW1, brow, bcol, 1024, acc);
    EPI256_BEGIN
      float y[16], g[16], b[16]; load16_bf(ys + (size_t)row * LDP + col, y); bft* gp = G0 + (size_t)row * 2048 + col; load16_bf(gp, g); load16_f(p.s5_glu_b + col, b);
#pragma unroll
      for (int i = 0; i < 16; ++i) v[i] = y[i] * sigm(v[i] + b[i]) * g[i];
      store16_bf(gp, v);
    EPI_END
  }
  convert_p(p, 0);
}

DI void phase_outproj0(const Params& p) {
  int tix_ = threadIdx.x; asm volatile("" : "+v"(tix_));
  const bft* G0 = (const bft*)(p.ws + OFF_G0); bft* hb = (bft*)(p.ws + OFF_U);
  for (int r_ = 0, it; xcd_item(r_, 4, T / 256, it); ++r_) {
    int brow = (it >> 2) * 256, bcol = (it & 3) * 256;
    int tid = tix_; asm volatile("" : "+v"(tid));
    f32x4 acc[8][4]; ACC256_ZERO(acc);
    g256_mainloop(tid, G0, 2048, (const bft*)(p.ws + OFF_Wout0), LDW2, brow, bcol, 2048, acc);
    EPI256_BEGIN
      float x[16]; load16_f(xrow(p, row) + col, x);
#pragma unroll
      for (int i = 0; i < 16; ++i) v[i] += x[i];
      store16_f(p.out + (size_t)row * 1024 + col, v); store16_bf(hb + (size_t)row * 1024 + col, v);
    EPI_END
  }
}

DI void phase_ple(const Params& p, int layer, const bft* hbin, bft* hbout, int ldo, float* ssq) {
  int tix_ = threadIdx.x; asm volatile("" : "+v"(tix_));
  const bft* pb = (const bft*)(p.ws + OFF_LAT);
  for (int r_ = 0, it; xcd_item(r_, 8, T / 256, it); ++r_) {
    int brow = (it >> 3) * 256, bcol = (it & 7) * 128;
    int tid = tix_; asm volatile("" : "+v"(tid));
    f32x4 acc[4][4], acc2[4][4]; ACC_ZERO(acc); ACC_ZERO(acc2);
    gemm_mainloop(tid, hbin, 1024, (const bft*)(p.ws + OFF_Wpg + layer * SZ_Wsq), LDW1, brow, bcol, 1024, acc);
    gemm_mainloop(tid, pb, 256, (const bft*)(p.ws + OFF_Wpw + layer * SZ_Wpw), LDWS, brow, bcol, 256, acc2);
    EPI_BEGIN
      float v2[16]; epi_stage(tid, acc2[m], v2); float h[16]; float* hp = p.out + (size_t)row * 1024 + col; load16_f(hp, h); float ss = 0.f;
#pragma unroll
      for (int i = 0; i < 16; ++i) { h[i] += sigm(v[i]) * v2[i]; ss += h[i] * h[i]; }
      store16_f(hp, h); if (hbout) store16_bf(hbout + (size_t)row * ldo + col, h);
      ss += __shfl_xor(ss, 1); ss += __shfl_xor(ss, 2);
      if ((lane & 3) == 0) atomicAdd(ssq + row, ss);
    EPI_END
  }
}

DI void phase_inproj1(const Params& p, int ch) {
  int tix_ = threadIdx.x; asm volatile("" : "+v"(tix_));
  const bft* hb = (const bft*)(p.ws + OFF_A); bft* Z = (bft*)(p.ws + OFF_U); const float* ssq1 = (const float*)(p.ws + OFF_SSQ1);
  const bft* Bt = (const bft*)(p.ws + OFF_W1t) + (size_t)ch * 1024 * LDW1;
  for (int r_ = 0, it; xcd_item(r_, 4, T / 256, it); ++r_) {
    int brow = (it >> 2) * 256, bcol = (it & 3) * 256;
    int tid = tix_; asm volatile("" : "+v"(tid));
    f32x4 acc[8][4]; ACC256_ZERO(acc);
    g256_mainloop(tid, hb, LDP, Bt, LDW1, brow, bcol, 1024, acc);
    const bool isgate = bcol >= 768;
    EPI256_BEGIN
      float rs = rsqrtf(ssq1[row] * (1.f / 1024) + EPS);
#pragma unroll
      for (int i = 0; i < 16; ++i) { v[i] *= rs; if (isgate) v[i] = siluf(v[i]); }
      store16_bf(Z + (size_t)row * 1024 + col, v);
    EPI_END
  }
}
DI void phase_filter(const Params& p, int ch) {
  int tix_ = threadIdx.x; asm volatile("" : "+v"(tix_));
  const int tid = tix_;
  const float* h2t = (const float*)(p.ws + OFF_H2); float* kraw = (float*)(p.ws + OFF_KRAW);
  const float mind = -3.0701134573253945f, maxd = -15.350567286626973f;
  float* w3s = (float*)smem;
  for (int it = blockIdx.x; it < 192; it += gridDim.x) {
    int Lsel = it < 128 ? 0 : 1; int r = Lsel ? it - 128 : it; int L = Lsel ? 4096 : 8192; int nlb = L / 512;
    int cq = r & 3; r >>= 2; int lb = r % nlb, dir = r / nlb; int l = lb * 512 + tid; int cc0 = cq * 64, c0 = ch * 256 + cc0;
    const float* w3 = p.hy_f_w3 + (size_t)dir * 64 * 2048 + c0;
    for (int e = tid; e < 4096; e += NTHR) w3s[e] = w3[(size_t)(e >> 6) * 2048 + (e & 63)];
    const float* h2 = h2t + (Lsel ? (size_t)8192 * 2 * 64 : 0) + (size_t)dir * 64 * L + l;
    float hv[64];
#pragma unroll
    for (int j = 0; j < 64; ++j) hv[j] = h2[(size_t)j * L];
    __syncthreads();
    float* kr = kraw + (Lsel ? (size_t)16384 * 256 : 0); const int N = 2 * L; const float tl = (float)l / (float)(L - 1);
#pragma unroll 1
    for (int c4 = 0; c4 < 16; ++c4) {
      float a0 = 0.f, a1 = 0.f, a2 = 0.f, a3 = 0.f;
#pragma unroll
      for (int j = 0; j < 64; ++j) { f32x4 w = *(const f32x4*)(w3s + j * 64 + c4 * 4); a0 += hv[j] * w[0]; a1 += hv[j] * w[1]; a2 += hv[j] * w[2]; a3 += hv[j] * w[3]; }
      float av[4] = {a0, a1, a2, a3};
#pragma unroll
      for (int i = 0; i < 4; ++i) { int cl = c4 * 4 + i; float delta = fabsf(mind + (float)(c0 + cl) * ((maxd - mind) / 2047.f)); float k = av[i] * __expf(-tl * delta);
        float* row = kr + (size_t)(cc0 + cl) * N;
        if (dir == 0) row[l] = k; else if (l > 0) row[N - l] = k; else row[L] = 0.f; }
    }
    __syncthreads();
  }
}
DI float conv3_at(const bft* Z, int tok, int pos, int L, int col, float w0, float w1, float w2, float b) {
  float xm = pos > 0 ? bf2f(Z[(size_t)(tok - 1) * 1024 + col]) : 0.f, x0 = bf2f(Z[(size_t)tok * 1024 + col]), xp = pos < L - 1 ? bf2f(Z[(size_t)(tok + 1) * 1024 + col]) : 0.f;
  return xm * w0 + x0 * w1 + xp * w2 + b;
}
DI float2 twid(float r) { return float2{__builtin_amdgcn_cosf(r), -__builtin_amdgcn_sinf(r)}; }
DI void bfly_fwd(float2 a0, float2 a1, float2 a2, float2 a3, float r, float2& o0, float2& o1, float2& o2, float2& o3) {
  float2 t0 = {a0.x + a2.x, a0.y + a2.y}, t1 = {a0.x - a2.x, a0.y - a2.y}, t2 = {a1.x + a3.x, a1.y + a3.y}, t3 = {a1.x - a3.x, a1.y - a3.y};
  float2 b0 = {t0.x + t2.x, t0.y + t2.y}, b2 = {t0.x - t2.x, t0.y - t2.y}, b1 = {t1.x + t3.y, t1.y - t3.x}, b3 = {t1.x - t3.y, t1.y + t3.x};
  float2 w1 = twid(r), w2 = cmul(w1, w1), w3 = cmul(w2, w1);
  o0 = b0; o1 = cmul(b1, w1); o2 = cmul(b2, w2); o3 = cmul(b3, w3);
}
DI void bfly_inv(float2 s0, float2 s1, float2 s2, float2 s3, float r, float2& o0, float2& o1, float2& o2, float2& o3) {
  float2 w1 = twid(r), w2 = cmul(w1, w1), w3 = cmul(w2, w1);
  float2 c0 = s0, c1 = cmulc(s1, w1), c2 = cmulc(s2, w2), c3 = cmulc(s3, w3);
  float2 t0 = {c0.x + c2.x, c0.y + c2.y}, t1 = {c0.x - c2.x, c0.y - c2.y}, t2 = {c1.x + c3.x, c1.y + c3.y}, t3 = {c1.x - c3.x, c1.y - c3.y};
  o0 = float2{t0.x + t2.x, t0.y + t2.y}; o2 = float2{t0.x - t2.x, t0.y - t2.y}; o1 = float2{t1.x - t3.y, t1.y + t3.x}; o3 = float2{t1.x + t3.y, t1.y - t3.x};
}
template <int N, int NBT = 1> DI void fft_level_fwd(float2* z0, int tid, int lq) {
  const int Q = 1 << lq; const float invM = 1.f / (float)(4 << lq);
  for (int bb = tid; bb < NBT * (N / 4); bb += NTHR) { const int b = bb & (N / 4 - 1); float2* z = z0 + (bb / (N / 4)) * N; int j = b & (Q - 1), base = ((b >> lq) << (lq + 2)) + j; float2 o0, o1, o2, o3;
    bfly_fwd(z[base], z[base + Q], z[base + 2 * Q], z[base + 3 * Q], (float)j * invM, o0, o1, o2, o3);
    z[base] = o0; z[base + Q] = o1; z[base + 2 * Q] = o2; z[base + 3 * Q] = o3; }
  __syncthreads();
}
template <int N, int NBT = 1> DI void fft_level_inv(float2* z0, int tid, int lq) {
  const int Q = 1 << lq; const float invM = 1.f / (float)(4 << lq);
  for (int bb = tid; bb < NBT * (N / 4); bb += NTHR) { const int b = bb & (N / 4 - 1); float2* z = z0 + (bb / (N / 4)) * N; int j = b & (Q - 1), base = ((b >> lq) << (lq + 2)) + j; float2 o0, o1, o2, o3;
    bfly_inv(z[base], z[base + Q], z[base + 2 * Q], z[base + 3 * Q], (float)j * invM, o0, o1, o2, o3);
    z[base] = o0; z[base + Q] = o1; z[base + 2 * Q] = o2; z[base + 3 * Q] = o3; }
  __syncthreads();
}
template <int N, int NBT = 1> DI void fft_pair_fwd(float2* z0, int tid, int lq1) {
  const int lq2 = lq1 - 2, Q1 = 1 << lq1, Q2 = 1 << lq2; const float invM1 = 1.f / (float)(4 << lq1), invM2 = 1.f / (float)(4 << lq2);
  for (int gg = tid; gg < NBT * (N / 16); gg += NTHR) { const int g = gg & (N / 16 - 1); float2* z = z0 + (gg / (N / 16)) * N; const int jp = g & (Q2 - 1), base = ((g >> lq2) << (lq2 + 4)) + jp; float2 x[4][4];
#pragma unroll
    for (int q1 = 0; q1 < 4; ++q1)
#pragma unroll
      for (int q2 = 0; q2 < 4; ++q2) x[q1][q2] = z[base + q1 * Q1 + q2 * Q2];
#pragma unroll
    for (int q2 = 0; q2 < 4; ++q2) bfly_fwd(x[0][q2], x[1][q2], x[2][q2], x[3][q2], (float)(jp + q2 * Q2) * invM1, x[0][q2], x[1][q2], x[2][q2], x[3][q2]);
#pragma unroll
    for (int q1 = 0; q1 < 4; ++q1) bfly_fwd(x[q1][0], x[q1][1], x[q1][2], x[q1][3], (float)jp * invM2, x[q1][0], x[q1][1], x[q1][2], x[q1][3]);
#pragma unroll
    for (int q1 = 0; q1 < 4; ++q1)
#pragma unroll
      for (int q2 = 0; q2 < 4; ++q2) z[base + q1 * Q1 + q2 * Q2] = x[q1][q2]; }
  __syncthreads();
}
template <int N, int NBT = 1> DI void fft_pair_inv(float2* z0, int tid, int lq2) {
  const int lq1 = lq2 + 2, Q1 = 1 << lq1, Q2 = 1 << lq2; const float invM1 = 1.f / (float)(4 << lq1), invM2 = 1.f / (float)(4 << lq2);
  for (int gg = tid; gg < NBT * (N / 16); gg += NTHR) { const int g = gg & (N / 16 - 1); float2* z = z0 + (gg / (N / 16)) * N; const int jp = g & (Q2 - 1), base = ((g >> lq2) << (lq2 + 4)) + jp; float2 x[4][4];
#pragma unroll
    for (int q1 = 0; q1 < 4; ++q1)
#pragma unroll
      for (int q2 = 0; q2 < 4; ++q2) x[q1][q2] = z[base + q1 * Q1 + q2 * Q2];
#pragma unroll
    for (int q1 = 0; q1 < 4; ++q1) bfly_inv(x[q1][0], x[q1][1], x[q1][2], x[q1][3], (float)jp * invM2, x[q1][0], x[q1][1], x[q1][2], x[q1][3]);
#pragma unroll
    for (int q2 = 0; q2 < 4; ++q2) bfly_inv(x[0][q2], x[1][q2], x[2][q2], x[3][q2], (float)(jp + q2 * Q2) * invM1, x[0][q2], x[1][q2], x[2][q2], x[3][q2]);
#pragma unroll
    for (int q1 = 0; q1 < 4; ++q1)
#pragma unroll
      for (int q2 = 0; q2 < 4; ++q2) z[base + q1 * Q1 + q2 * Q2] = x[q1][q2]; }
  __syncthreads();
}
template <int N, int NBT = 1> DI void fft_level0_inv_mul(float2* z0, int tid, const float2* kh) {
  for (int bb = tid; bb < NBT * (N / 4); bb += NTHR) { const int b = bb & (N / 4 - 1); float2* z = z0 + (bb / (N / 4)) * N; const int base = b * 4; f32x4 k01 = *(const f32x4*)(kh + base), k23 = *(const f32x4*)(kh + base + 2); float2 o0, o1, o2, o3;
    bfly_inv(cmul(z[base], float2{k01[0], k01[1]}), cmul(z[base + 1], float2{k01[2], k01[3]}), cmul(z[base + 2], float2{k23[0], k23[1]}), cmul(z[base + 3], float2{k23[2], k23[3]}), 0.f, o0, o1, o2, o3);
    z[base] = o0; z[base + 1] = o1; z[base + 2] = o2; z[base + 3] = o3; }
  __syncthreads();
}
template <int LOGN, bool R2DONE = false> DI void fft_fwd(float2* z, int tid) {
  constexpr int N = 1 << LOGN;
  if constexpr (LOGN & 1) {
    if constexpr (!R2DONE) {
      for (int b = tid; b < N / 2; b += NTHR) { float2 a0 = z[b], a1 = z[b + N / 2]; float2 w = twid((float)b * (1.f / N));
        z[b] = float2{a0.x + a1.x, a0.y + a1.y}; z[b + N / 2] = cmul(float2{a0.x - a1.x, a0.y - a1.y}, w); }
      __syncthreads();
    }
    fft_pair_fwd<N>(z, tid, 10); fft_pair_fwd<N>(z, tid, 6); fft_level_fwd<N>(z, tid, 2); fft_level_fwd<N>(z, tid, 0);
  } else {
    if constexpr (!R2DONE) fft_level_fwd<N>(z, tid, 12);
    fft_pair_fwd<N>(z, tid, 10); fft_pair_fwd<N>(z, tid, 6); fft_level_fwd<N>(z, tid, 2); fft_level_fwd<N>(z, tid, 0);
  }
}
template <int LOGN> DI void fft_inv_mul(float2* z, int tid, const float2* kh) {
  constexpr int N = 1 << LOGN;
  fft_level0_inv_mul<N>(z, tid, kh);
  if constexpr (LOGN & 1) { fft_level_inv<N>(z, tid, 2); fft_pair_inv<N>(z, tid, 4); fft_pair_inv<N>(z, tid, 8); }
  else { fft_level_inv<N>(z, tid, 2); fft_pair_inv<N>(z, tid, 4); fft_pair_inv<N>(z, tid, 8); }
}
DI void fft2x13_fwd(float2* z, int tid) { constexpr int N = 8192;
  fft_pair_fwd<N, 2>(z, tid, 10); fft_pair_fwd<N, 2>(z, tid, 6); fft_level_fwd<N, 2>(z, tid, 2); fft_level_fwd<N, 2>(z, tid, 0); }
DI void fft2x13_inv_mul(float2* z, int tid, const float2* kh) { constexpr int N = 8192;
  fft_level0_inv_mul<N, 2>(z, tid, kh); fft_level_inv<N, 2>(z, tid, 2); fft_pair_inv<N, 2>(z, tid, 4); fft_pair_inv<N, 2>(z, tid, 8); }
template <int LOGN> DI void filtfft_item(const Params& p, int ch, int cc, const float* kr, float2* kh) {
  constexpr int N = 1 << LOGN; int tid = threadIdx.x; asm volatile("" : "+v"(tid)); float2* z = (float2*)smem; float* redbuf = (float*)(smem + 131072);
  float ss = 0.f;
  if constexpr (LOGN & 1) {
    for (int i = tid; i < N / 2; i += NTHR) { float k0 = kr[i], k1 = kr[i + N / 2]; ss += k0 * k0 + k1 * k1; float2 w = twid((float)i * (1.f / N)); float d = k0 - k1;
      z[i] = float2{k0 + k1, 0.f}; z[i + N / 2] = float2{d * w.x, d * w.y}; }
  } else {
    constexpr int Q = N / 4;
    for (int i = tid; i < Q; i += NTHR) { float k0 = kr[i], k1 = kr[i + Q], k2 = kr[i + 2 * Q], k3 = kr[i + 3 * Q]; ss += k0 * k0 + k1 * k1 + k2 * k2 + k3 * k3; float2 o0, o1, o2, o3;
      bfly_fwd(float2{k0, 0.f}, float2{k1, 0.f}, float2{k2, 0.f}, float2{k3, 0.f}, (float)i * (1.f / N), o0, o1, o2, o3);
      z[i] = o0; z[i + Q] = o1; z[i + 2 * Q] = o2; z[i + 3 * Q] = o3; }
  }
  ss = wave_sum(ss); if ((tid & 63) == 0) redbuf[tid >> 6] = ss;
  __syncthreads();
  float tot = 0.f;
#pragma unroll
  for (int w = 0; w < 8; ++w) tot += redbuf[w];
  const float nrm = rsqrtf(tot + EPS) * (1.f / N), bias = p.hy_bias[ch * 256 + cc] * (1.f / N);
  fft_fwd<LOGN, true>(z, tid);
  for (int i = tid; i < N; i += NTHR) { float2 v = z[i]; kh[i] = float2{v.x * nrm + bias, v.y * nrm}; }
  __syncthreads();
}
DI void phase_vx(const Params& p, int ch) {
  int tix_ = threadIdx.x; asm volatile("" : "+v"(tix_));
  const bft* Z = (const bft*)(p.ws + OFF_U); bft* vxT = (bft*)(p.ws + OFF_VXT);
  const float* kraw = (const float*)(p.ws + OFF_KRAW); float2* khat = (float2*)(p.ws + OFF_KHAT);
  const int tid = tix_; float* tile = (float*)smem;
  const float* cw = p.hy_conv_w; const float* cb = p.hy_conv_b;
  for (int it = blockIdx.x; it < 512; it += gridDim.x) {
    int cc = it & 255;
    if (it < 256) filtfft_item<14>(p, ch, cc, kraw + (size_t)cc * 16384, khat + (size_t)cc * 16384);
    else filtfft_item<13>(p, ch, cc, kraw + (size_t)16384 * 256 + (size_t)cc * 8192, khat + (size_t)16384 * 256 + (size_t)cc * 8192);
  }
  for (int it = blockIdx.x; it < T / 64; it += gridDim.x) {
    const int tok0 = it * 64;
#pragma unroll 1
    for (int rr = 0; rr < 4; ++rr) { int e = tid + rr * 512; int tl = e >> 5, cg = e & 31; int tok = tok0 + tl, cc = cg * 8, c = ch * 256 + cc; int pos = tok_pos(tok), L = tok_len(tok);
      const bft* zr = Z + (size_t)tok * 1024; u32x4 zero = {0, 0, 0, 0};
      u32x4 x1m = pos > 0 ? *(const u32x4*)(zr - 1024 + 256 + cc) : zero, x10 = *(const u32x4*)(zr + 256 + cc), x1p = pos < L - 1 ? *(const u32x4*)(zr + 1024 + 256 + cc) : zero;
      u32x4 vm = pos > 0 ? *(const u32x4*)(zr - 1024 + 512 + cc) : zero, v0 = *(const u32x4*)(zr + 512 + cc), vp = pos < L - 1 ? *(const u32x4*)(zr + 1024 + 512 + cc) : zero;
#pragma unroll
      for (int i = 0; i < 8; ++i) { int sh = (i & 1) ? 0 : 16; unsigned msk = 0xffff0000u; int w = i >> 1;
        float a = __uint_as_float((x1m[w] << sh) & msk), b = __uint_as_float((x10[w] << sh) & msk), d = __uint_as_float((x1p[w] << sh) & msk);
        float e0 = __uint_as_float((vm[w] << sh) & msk), e1 = __uint_as_float((v0[w] << sh) & msk), e2 = __uint_as_float((vp[w] << sh) & msk);
        int ci = c + i;
        float x1 = a * cw[2048 + ci] + b * cw[6144 + 2048 + ci] + d * cw[12288 + 2048 + ci] + cb[2048 + ci];
        float vv = e0 * cw[4096 + ci] + e1 * cw[6144 + 4096 + ci] + e2 * cw[12288 + 4096 + ci] + cb[4096 + ci];
        tile[tl * 257 + cc + i] = vv * x1; } }
    __syncthreads();
    { int cl = tid >> 1, th = (tid & 1) * 32; bft* dst = vxT + (size_t)cl * T + tok0 + th;
#pragma unroll
      for (int q = 0; q < 4; ++q) { u32x4 o;
#pragma unroll
        for (int k = 0; k < 4; ++k) o[k] = pack2(tile[(th + q * 8 + 2 * k) * 257 + cl], tile[(th + q * 8 + 2 * k + 1) * 257 + cl]);
        *(u32x4*)(dst + q * 8) = o; } }
    __syncthreads();
  }
}
template <int LOGN> DI void fftconv_item(bft* xa, bft* xb, const float2* kh) {
  constexpr int N = 1 << LOGN, L = N / 2; int tid = threadIdx.x; asm volatile("" : "+v"(tid)); float2* z = (float2*)smem;
  if constexpr (LOGN & 1) {
    for (int i = 2 * tid; i < L; i += 2 * NTHR) { unsigned wa = *(const unsigned*)(xa + i), wb = *(const unsigned*)(xb + i);
      float2 x0 = {__uint_as_float(wa << 16), __uint_as_float(wb << 16)}, x1 = {__uint_as_float(wa & 0xffff0000u), __uint_as_float(wb & 0xffff0000u)};
      z[i] = x0; z[i + 1] = x1;
      z[L + i] = cmul(x0, twid((float)i * (1.f / N))); z[L + i + 1] = cmul(x1, twid((float)(i + 1) * (1.f / N))); }
  } else {
    constexpr int Q = N / 4; const float2 zero = {0.f, 0.f};
    for (int i = 2 * tid; i < Q; i += 2 * NTHR) { unsigned wa = *(const unsigned*)(xa + i), wb = *(const unsigned*)(xb + i), wc = *(const unsigned*)(xa + Q + i), wd = *(const unsigned*)(xb + Q + i);
#pragma unroll
      for (int e = 0; e < 2; ++e) { float2 a0 = e ? float2{__uint_as_float(wa & 0xffff0000u), __uint_as_float(wb & 0xffff0000u)} : float2{__uint_as_float(wa << 16), __uint_as_float(wb << 16)};
        float2 a1 = e ? float2{__uint_as_float(wc & 0xffff0000u), __uint_as_float(wd & 0xffff0000u)} : float2{__uint_as_float(wc << 16), __uint_as_float(wd << 16)};
        float2 o0, o1, o2, o3; bfly_fwd(a0, a1, zero, zero, (float)(i + e) * (1.f / N), o0, o1, o2, o3);
        z[i + e] = o0; z[i + e + Q] = o1; z[i + e + 2 * Q] = o2; z[i + e + 3 * Q] = o3; } }
  }
  __syncthreads();
  fft_fwd<LOGN, true>(z, tid);
  fft_inv_mul<LOGN>(z, tid, kh);
  if constexpr (LOGN & 1) {
    for (int i = 2 * tid; i < L; i += 2 * NTHR) { float2 v0 = z[i], v1 = z[i + 1];
      float2 c0 = cmulc(z[L + i], twid((float)i * (1.f / N))), c1 = cmulc(z[L + i + 1], twid((float)(i + 1) * (1.f / N))); v0.x += c0.x; v0.y += c0.y; v1.x += c1.x; v1.y += c1.y;
      *(unsigned*)(xa + i) = pack2(v0.x, v1.x); *(unsigned*)(xb + i) = pack2(v0.y, v1.y); }
  } else {
    constexpr int Q = N / 4;
    for (int i = 2 * tid; i < Q; i += 2 * NTHR) { float2 r0[2], r1[2];
#pragma unroll
      for (int e = 0; e < 2; ++e) { float2 o2, o3; bfly_inv(z[i + e], z[i + e + Q], z[i + e + 2 * Q], z[i + e + 3 * Q], (float)(i + e) * (1.f / N), r0[e], r1[e], o2, o3); }
      *(unsigned*)(xa + i) = pack2(r0[0].x, r0[1].x); *(unsigned*)(xb + i) = pack2(r0[0].y, r0[1].y);
      *(unsigned*)(xa + Q + i) = pack2(r1[0].x, r1[1].x); *(unsigned*)(xb + Q + i) = pack2(r1[0].y, r1[1].y); }
  }
  __syncthreads();
}
DI void fftconv2_item(bft* x, const float2* kh) {
  constexpr int N = 8192, L = 4096; int tid = threadIdx.x; asm volatile("" : "+v"(tid)); float2* z0 = (float2*)smem;
  for (int ii = 2 * tid; ii < 2 * L; ii += 2 * NTHR) { const int sel = ii >= L ? 1 : 0, i = ii - sel * L; bft* xa = x + sel * 2 * L; bft* xb = xa + L; float2* z = z0 + sel * N;
    unsigned wa = *(const unsigned*)(xa + i), wb = *(const unsigned*)(xb + i);
    float2 x0 = {__uint_as_float(wa << 16), __uint_as_float(wb << 16)}, x1 = {__uint_as_float(wa & 0xffff0000u), __uint_as_float(wb & 0xffff0000u)};
    z[i] = x0; z[i + 1] = x1; z[L + i] = cmul(x0, twid((float)i * (1.f / N))); z[L + i + 1] = cmul(x1, twid((float)(i + 1) * (1.f / N))); }
  __syncthreads();
  fft2x13_fwd(z0, tid);
  fft2x13_inv_mul(z0, tid, kh);
  for (int ii = 2 * tid; ii < 2 * L; ii += 2 * NTHR) { const int sel = ii >= L ? 1 : 0, i = ii - sel * L; bft* xa = x + sel * 2 * L; bft* xb = xa + L; float2* z = z0 + sel * N;
    float2 v0 = z[i], v1 = z[i + 1];
    float2 c0 = cmulc(z[L + i], twid((float)i * (1.f / N))), c1 = cmulc(z[L + i + 1], twid((float)(i + 1) * (1.f / N))); v0.x += c0.x; v0.y += c0.y; v1.x += c1.x; v1.y += c1.y;
    *(unsigned*)(xa + i) = pack2(v0.x, v1.x); *(unsigned*)(xb + i) = pack2(v0.y, v1.y); }
  __syncthreads();
}
DI void phase_conv(const Params& p, int ch) {
  int tix_ = threadIdx.x; asm volatile("" : "+v"(tix_));
  bft* vxT = (bft*)(p.ws + OFF_VXT); const float2* khat = (const float2*)(p.ws + OFF_KHAT);
  for (int it = blockIdx.x; it < 768; it += gridDim.x) {
    int cc = it & 255; bft* row = vxT + (size_t)cc * T;
    if (it < 256) fftconv_item<14>(row, row + 8192, khat + (size_t)cc * 16384);
    else { int pq = (it - 256) >> 8; fftconv2_item(row + TP + (4 * pq) * 4096, khat + (size_t)16384 * 256 + (size_t)cc * 8192); }
  }
}
DI void phase_gate(const Params& p, int ch) {
  int tix_ = threadIdx.x; asm volatile("" : "+v"(tix_));
  const bft* Z = (const bft*)(p.ws + OFF_U); const bft* yT = (const bft*)(p.ws + OFF_VXT); bft* G1 = (bft*)(p.ws + OFF_G1H) + (ch & 3) * 256;
  const int tid = tix_; float* tile = (float*)smem;
  const float* cw = p.hy_conv_w; const float* cb = p.hy_conv_b;
  for (int it = blockIdx.x; it < T / 64; it += gridDim.x) {
    const int tok0 = it * 64;
    { int cl = tid >> 1, th = (tid & 1) * 32; const bft* s = yT + (size_t)cl * T + tok0 + th;
#pragma unroll
      for (int q = 0; q < 4; ++q) { u32x4 v = *(const u32x4*)(s + q * 8);
#pragma unroll
        for (int k = 0; k < 4; ++k) { tile[cl * 65 + th + q * 8 + 2 * k] = __uint_as_float(v[k] << 16); tile[cl * 65 + th + q * 8 + 2 * k + 1] = __uint_as_float(v[k] & 0xffff0000u); } } }
    __syncthreads();
#pragma unroll 1
    for (int rr = 0; rr < 4; ++rr) { int e = tid + rr * 512; int tl = e >> 5, cg = e & 31; int tok = tok0 + tl, cc = cg * 8, c = ch * 256 + cc; int pos = tok_pos(tok), L = tok_len(tok);
      const bft* zr = Z + (size_t)tok * 1024; u32x4 zero = {0, 0, 0, 0};
      u32x4 xm = pos > 0 ? *(const u32x4*)(zr - 1024 + cc) : zero, x0 = *(const u32x4*)(zr + cc), xp = pos < L - 1 ? *(const u32x4*)(zr + 1024 + cc) : zero, gt = *(const u32x4*)(zr + 768 + cc);
      float o[8];
#pragma unroll
      for (int i = 0; i < 8; ++i) { int sh = (i & 1) ? 0 : 16; unsigned msk = 0xffff0000u; int w = i >> 1;
        float a = __uint_as_float((xm[w] << sh) & msk), b = __uint_as_float((x0[w] << sh) & msk), d = __uint_as_float((xp[w] << sh) & msk), g = __uint_as_float((gt[w] << sh) & msk);
        int ci = c + i; float xc = a * cw[ci] + b * cw[6144 + ci] + d * cw[12288 + ci] + cb[ci];
        o[i] = tile[(cc + i) * 65 + tl] * xc * g; }
      u32x4 w = {pack2(o[0], o[1]), pack2(o[2], o[3]), pack2(o[4], o[5]), pack2(o[6], o[7])};
      *(u32x4*)(G1 + (size_t)tok * 1024 + cc) = w; }
    __syncthreads();
  }
}
DI void phase_outproj1(const Params& p, int hh) {
  int tix_ = threadIdx.x; asm volatile("" : "+v"(tix_));
  const bft* G1 = (const bft*)(p.ws + OFF_G1H); bft* hb3 = (bft*)(p.ws + OFF_HB3);
  const bft* Bt = (const bft*)(p.ws + OFF_Wout1) + hh * 1024;
  for (int r_ = 0, it; xcd_item(r_, 4, T / 256, it); ++r_) {
    int brow = (it >> 2) * 256, bcol = (it & 3) * 256;
    int tid = tix_; asm volatile("" : "+v"(tid));
    f32x4 acc[8][4]; ACC256_ZERO(acc);
    g256_mainloop(tid, G1, 1024, Bt, LDW2, brow, bcol, 1024, acc);
    EPI256_BEGIN
      float h[16]; float* hp = p.out + (size_t)row * 1024 + col; load16_f(hp, h);
#pragma unroll
      for (int i = 0; i < 16; ++i) h[i] += v[i];
      store16_f(hp, h); if (hh == 1) store16_bf(hb3 + (size_t)row * 1024 + col, h);
    EPI_END
  }
}
DI void phase_final(const Params& p) {
  int tix_ = threadIdx.x; asm volatile("" : "+v"(tix_));
  const int lane = tix_ & 63, wid = tix_ >> 6; const float* ssq = (const float*)(p.ws + OFF_SSQF);
  for (int it = blockIdx.x; it < T / 8; it += gridDim.x) {
    int tok = it * 8 + wid; float rs = rsqrtf(ssq[tok] * (1.f / 1024) + EPS); float* hr = p.out + (size_t)tok * 1024;
    for (int i = 0; i < 4; ++i) { f32x4 v = *(f32x4*)(hr + i * 256 + lane * 4); f32x4 g = *(const f32x4*)(p.final_g + i * 256 + lane * 4);
      v[0] *= rs * g[0]; v[1] *= rs * g[1]; v[2] *= rs * g[2]; v[3] *= rs * g[3]; *(f32x4*)(hr + i * 256 + lane * 4) = v; }
  }
}

__global__ void __launch_bounds__(NTHR) mega(Params p) {
  cg::grid_group grid = cg::this_grid();
  if (threadIdx.x == 0) xb_words = make_uint4(0u, 0u, 0u, 0u);
  __syncthreads();
  XcdBarrier xb = xcd_barrier_post((unsigned*)(p.ws + OFF_BAR), (volatile LAS unsigned*)&xb_words);
#define GSYNC() xcd_barrier(xb)
  phase_prep(p); GSYNC();
  if (threadIdx.x == 0) { unsigned idx = 0; for (unsigned j = 0; j < xb.x; ++j) idx += xb_ld(&xb.bar[XB_XCNT(j)]) > 0u ? 1u : 0u; xb_words.w = idx; }
  __syncthreads();
  phase_inproj0(p); grid.sync();
  phase_mlaprep(p); phase_s5gen(p); GSYNC();
  phase_s5step1(p); GSYNC();
  phase_s5scan(p); GSYNC();
  phase_s5step3(p); GSYNC();
  for (int sg = 0; sg < 3; ++sg) { phase_upproj(p, sg); GSYNC(); phase_attn(p, sg); GSYNC(); }
  phase_glu(p); GSYNC();
  phase_outproj0(p); GSYNC();
  phase_ple(p, 0, (const bft*)(p.ws + OFF_U), (bft*)(p.ws + OFF_A), LDP, (float*)(p.ws + OFF_SSQ1)); GSYNC();
  convert_p(p, 1);
  for (int ch = 0; ch < 8; ++ch) {
    if (ch == 4) phase_outproj1(p, 0);
    phase_inproj1(p, ch); phase_filter(p, ch); GSYNC();
    phase_vx(p, ch); GSYNC();
    phase_conv(p, ch); GSYNC();
    phase_gate(p, ch); GSYNC();
  }
  phase_outproj1(p, 1); GSYNC();
  phase_ple(p, 1, (const bft*)(p.ws + OFF_HB3), nullptr, 1024, (float*)(p.ws + OFF_SSQF)); GSYNC();
  phase_final(p);
}

extern "C" void kernel_launch(void* const* d_in, const int* in_sizes, int n_in, void* d_out, int out_size, void* d_ws, size_t ws_size, hipStream_t stream) {
  static int grid_blocks = 0;
  if (!grid_blocks) {
    (void)hipFuncSetAttribute((const void*)mega, hipFuncAttributeMaxDynamicSharedMemorySize, (int)LDS_BYTES);
    int dev = 0, cus = 0, per_cu = 0;
    (void)hipGetDevice(&dev);
    (void)hipDeviceGetAttribute(&cus, hipDeviceAttributeMultiprocessorCount, dev);
    (void)hipOccupancyMaxActiveBlocksPerMultiprocessor(&per_cu, mega, NTHR, LDS_BYTES);
    if (per_cu < 1) per_cu = 1;
    if (per_cu > 1) per_cu = 1;
    grid_blocks = cus * per_cu;
    if (ws_size < OFF_BAR + XCD_BAR_WORDS * 4) fprintf(stderr, "ws too small: %zu < %zu\n", ws_size, (size_t)WS_END);
  }
  Params p{};
  const float** pp = (const float**)&p;
  for (int i = 0; i < 36; ++i) pp[i] = (const float*)d_in[i];
  p.out = (float*)d_out; p.ws = (char*)d_ws;
  for (int i = 0; i < 32; ++i) p.rope_inv[i] = 1.0 / pow(10000.0, (double)(2 * i) / 64.0);
  (void)hipMemsetAsync((char*)d_ws + OFF_BAR, 0, XCD_BAR_WORDS * sizeof(unsigned), stream);
  void* args[] = {&p};
  hipError_t e = hipLaunchCooperativeKernel((void*)mega, dim3(grid_blocks), dim3(NTHR), args, LDS_BYTES, stream);
  if (e != hipSuccess) fprintf(stderr, "cooperative launch failed: %s (grid %d)\n", hipGetErrorString(e), grid_blocks);
}
```

```cpp
#include <hip/hip_runtime.h>
#include <hip/hip_bf16.h>
#include <hip/hip_cooperative_groups.h>
#include <cstdio>
#include <cmath>
namespace cg = cooperative_groups;

#define DI __device__ __forceinline__
typedef unsigned short bft;
using bf16x8 = __attribute__((ext_vector_type(8))) short;
using s16x4  = __attribute__((ext_vector_type(4))) short;
using f32x4  = __attribute__((ext_vector_type(4))) float;
using f32x16 = __attribute__((ext_vector_type(16))) float;
using u32x4  = __attribute__((ext_vector_type(4))) unsigned;
using u32x2  = __attribute__((ext_vector_type(2))) unsigned;

constexpr int T = 49152, TP = 16384, DM = 1024;
constexpr float EPS = 1e-6f;
constexpr int NTHR = 512;
constexpr size_t LDS_BYTES = 147456;

constexpr int LDP = 1088, LDW1 = 1088, LDW2 = 2112, LDWQ = 448, LDWS = 320;
constexpr size_t SZ_W0t = 3840ull * LDW1 * 2, SZ_Wq = 1536ull * LDWQ * 2, SZ_Wkv = 2048ull * LDWS * 2, SZ_Wsq = 1024ull * LDW1 * 2;
constexpr size_t SZ_Wout = 1024ull * LDW2 * 2, SZ_Wpw = 1024ull * LDWS * 2, SZ_W1t = 8192ull * LDW1 * 2;
constexpr size_t OFF_W0t = 0, OFF_Wq = OFF_W0t + SZ_W0t, OFF_Wkv = OFF_Wq + SZ_Wq, OFF_Wglu = OFF_Wkv + SZ_Wkv, OFF_Wout0 = OFF_Wglu + SZ_Wsq;
constexpr size_t OFF_Wpg = OFF_Wout0 + SZ_Wout, OFF_Wpw = OFF_Wpg + 2 * SZ_Wsq, OFF_W1t = OFF_Wpw + 2 * SZ_Wpw, OFF_Wout1 = OFF_W1t + SZ_W1t;
constexpr size_t OFF_R0 = OFF_Wout1 + SZ_Wout, OFF_SSQ1 = OFF_R0 + T * 4, OFF_SSQF = OFF_SSQ1 + T * 4, OFF_HYSSQ = OFF_SSQF + T * 4;
constexpr size_t OFF_ROPE = OFF_HYSSQ + 2 * 2048 * 4, OFF_H2 = OFF_ROPE + 8192ull * 64 * 4;
constexpr size_t SZ_H2 = (8192ull + 4096) * 2 * 64 * 4;
constexpr size_t OFF_A = (OFF_H2 + SZ_H2 + 255) / 256 * 256;
constexpr size_t SZ_TB = (size_t)T * 1024 * 2;
constexpr size_t OFF_U = OFF_A + (size_t)T * LDP * 2;
constexpr size_t OFF_LAT = OFF_U + SZ_TB;
constexpr size_t SZ_LAT = (size_t)T * 704 * 2;
constexpr size_t OFF_G0 = OFF_LAT + SZ_LAT;
constexpr size_t SZ_G0 = (size_t)T * 2048 * 2;
constexpr size_t WS_END = OFF_G0 + SZ_G0;
constexpr size_t OFF_KRAW = OFF_LAT + 32ull * 1024 * 1024, SZ_KRAW = (16384ull + 8192) * 256 * 4;
static_assert(OFF_KRAW + SZ_KRAW <= OFF_G0, "kraw fits in LAT region");
constexpr size_t OFF_KHAT = OFF_G0, SZ_KHAT = (16384ull + 8192) * 256 * 8;
constexpr size_t OFF_VXT = OFF_KHAT + SZ_KHAT, SZ_VXT = (size_t)T * 256 * 4;
constexpr size_t OFF_G1H = OFF_VXT + SZ_VXT, SZ_G1H = (size_t)T * 1024 * 2;
static_assert(OFF_G1H + SZ_G1H <= WS_END, "layer1 layout");
constexpr size_t OFF_HB3 = OFF_U;
constexpr size_t OFF_BAR = (WS_END + 255) / 256 * 256;
static_assert(OFF_BAR + 16384 <= 536870912ull, "workspace budget");

#define XB_TMO      128
#define XB_XCNT(j)  (256  + 64 * (j))
#define XB_XSUB(j)  (1280 + 64 * (j))
#define XB_XGEN(j)  (2304 + 64 * (j))
#define XB_TOP      3328
#define XB_TOPGEN   3392
#define XCD_BAR_WORDS 3456
#define XB_SPIN_CAP (1u << 22)
#define LAS __attribute__((address_space(3)))
__device__ __forceinline__ unsigned xb_ld(unsigned* p)              { return __hip_atomic_load(p, __ATOMIC_RELAXED, __HIP_MEMORY_SCOPE_AGENT); }
__device__ __forceinline__ unsigned xb_add(unsigned* p, unsigned v) { return __hip_atomic_fetch_add(p, v, __ATOMIC_RELAXED, __HIP_MEMORY_SCOPE_AGENT); }
__device__ __forceinline__ unsigned xb_xcc_id() { return (unsigned)__builtin_amdgcn_s_getreg((3 << 11) | 20) & 0xFu; }
#define XB_SPIN(cond, bar) do { unsigned _sp = 0; while (cond) { __builtin_amdgcn_s_sleep(1); \
    if ((++_sp & 255u) == 0u) { if (xb_ld(&(bar)[XB_TMO])) break; if (_sp > XB_SPIN_CAP) { atomicAdd(&(bar)[XB_TMO], 1u); break; } } } } while (0)
struct XcdBarrier { unsigned* bar; unsigned x; volatile LAS unsigned* st; };
__device__ __forceinline__ XcdBarrier xcd_barrier_post(unsigned* bar, volatile LAS unsigned* st) {
  XcdBarrier b; b.bar = bar; b.x = (unsigned)__builtin_amdgcn_readfirstlane((int)xb_xcc_id()); b.st = st;
  if (threadIdx.x == 0) st[2] = xb_add(&bar[XB_XCNT(b.x)], 1u);
  return b;
}
__device__ __forceinline__ void xcd_barrier_complete(unsigned* bar, unsigned x, unsigned& nloc, unsigned& nx) {
  const unsigned G = gridDim.x * gridDim.y * gridDim.z;
  unsigned sum, cnt, mine, sp = 0u;
  for (;;) {
    sum = 0u; cnt = 0u; mine = 0u;
#pragma unroll
    for (unsigned j = 0; j < 16; ++j) { const unsigned c = xb_ld(&bar[XB_XCNT(j)]); sum += c; cnt += (c > 0u) ? 1u : 0u; mine = (j == x) ? c : mine; }
    if (sum == G) break;
    __builtin_amdgcn_s_sleep(1);
    if ((++sp & 255u) == 0u) { if (xb_ld(&bar[XB_TMO])) break; if (sp > XB_SPIN_CAP) { atomicAdd(&bar[XB_TMO], 1u); break; } }
  }
  nloc = mine > 0u ? mine : 1u; nx = cnt > 0u ? cnt : 1u;
}
__device__ __forceinline__ void xcd_barrier(const XcdBarrier& b) {
  asm volatile("s_waitcnt vmcnt(0)" ::: "memory");
  __syncthreads();
  if (threadIdx.x == 0) {
    unsigned* bar = b.bar; unsigned bx = b.x; asm volatile("" : "+s"(bx));
    __builtin_amdgcn_s_waitcnt(0);
    unsigned nloc = b.st[0], nx = b.st[1];
    if (nloc == 0u) { xcd_barrier_complete(bar, bx, nloc, nx); b.st[0] = nloc; b.st[1] = nx; }
    const unsigned old = xb_add(&bar[XB_XSUB(bx)], 1u);
    const unsigned gen = old / nloc;
    if (old + 1u == (gen + 1u) * nloc) {
      __builtin_amdgcn_fence(__ATOMIC_RELEASE, "agent");
      asm volatile("s_waitcnt vmcnt(0)" ::: "memory");
      const unsigned og = xb_add(&bar[XB_TOP], 1u);
      const unsigned tg = og / nx;
      if (og + 1u == (tg + 1u) * nx) xb_add(&bar[XB_TOPGEN], 1u);
      else XB_SPIN(xb_ld(&bar[XB_TOPGEN]) == tg, bar);
      __builtin_amdgcn_fence(__ATOMIC_ACQUIRE, "agent");
      xb_add(&bar[XB_XGEN(bx)], 1u);
      asm volatile("s_waitcnt vmcnt(0)" ::: "memory");
    } else {
      XB_SPIN(xb_ld(&bar[XB_XGEN(bx)]) == gen, bar);
      __builtin_amdgcn_fence(__ATOMIC_ACQUIRE, "agent");
      asm volatile("s_waitcnt vmcnt(0)" ::: "memory");
    }
  }
  __syncthreads();
}

struct Params {
  const float *x_prompt, *x_sample, *p_prompt, *p_sample, *norm_g, *final_g, *ple_w, *ple_gate_w, *ab_w_in, *ab_w_out;
  const float *s5_a_re, *s5_a_im, *s5_log_dt, *s5_b_re, *s5_b_im, *s5_c_re, *s5_c_im, *s5_d, *s5_glu_w, *s5_glu_b;
  const float *mla_q_norm, *mla_w_q_up, *mla_kv_norm, *mla_w_kv_up, *hy_w_in, *hy_w_out, *hy_conv_w, *hy_conv_b;
  const float *hy_f_w1, *hy_f_b1, *hy_f_freq1, *hy_f_w2, *hy_f_b2, *hy_f_freq2, *hy_f_w3, *hy_bias;
  float* out; char* ws;
  double rope_inv[32];
};

extern __shared__ __attribute__((aligned(16))) char smem[];

DI bft f2bf(float x) { unsigned u = __float_as_uint(x); u += 0x7fffu + ((u >> 16) & 1u); return (bft)(u >> 16); }
DI float bf2f(bft h) { return __uint_as_float(((unsigned)h) << 16); }
DI unsigned pack2(float a, float b) { return (unsigned)f2bf(a) | ((unsigned)f2bf(b) << 16); }
DI float2 cmul(float2 a, float2 b) { return float2{a.x * b.x - a.y * b.y, a.x * b.y + a.y * b.x}; }
DI float2 cmulc(float2 a, float2 b) { return float2{a.x * b.x + a.y * b.y, a.y * b.x - a.x * b.y}; }
DI float sigm(float x) { return 1.f / (1.f + __expf(-x)); }
DI float siluf(float x) { return x * sigm(x); }
DI float geluf(float x) { float z = 0.7978845608028654f * (x + 0.044715f * x * x * x); float t = 1.f - 2.f / (1.f + __expf(2.f * z)); return 0.5f * x * (1.f + t); }
DI void sincos_d(double ang, float& s, float& c) { double rev = ang * 0.15915494309189535; rev -= rint(rev); float r = (float)rev; s = __builtin_amdgcn_sinf(r); c = __builtin_amdgcn_cosf(r); }
DI float sin_f(float ang) { float rev = ang * 0.15915494309189535f; rev -= rintf(rev); return __builtin_amdgcn_sinf(rev); }
DI float wave_sum(float v) { for (int o = 32; o > 0; o >>= 1) v += __shfl_xor(v, o); return v; }
DI int tok_pos(int tok) { return tok < TP ? (tok & 8191) : (tok & 4095); }
DI int tok_len(int tok) { return tok < TP ? 8192 : 4096; }
__shared__ uint4 xb_words;
DI bool xcd_item(int r, int GS, int ngroups, int& item) {
  const int nb = (int)xb_words.x, nx = (int)xb_words.y, j = (int)xb_words.z, xcd = (int)xb_words.w;
  const int li = r * nb + j, gl = li / GS, gi = gl * nx + xcd;
  if (gi >= ngroups) return false;
  item = gi * GS + (li - gl * GS); return true;
}
DI const float* xrow(const Params& p, int tok) { return tok < TP ? p.x_prompt + (size_t)tok * 1024 : p.x_sample + (size_t)(tok - TP) * 1024; }

struct TrJob { const float* src; int ldsrc, srccol0, k0; bft* dst; int lddst, dstrow0; const float* g; };
DI bool get_trjob(const Params& p, int j, TrJob& o) {
  const int c1 = 944, c2 = c1 + 144, c3 = c2 + 128, c4 = c3 + 256, c5 = c4 + 512, c6 = c5 + 512, c7 = c6 + 128, c8 = c7 + 2048, c9 = c8 + 512;
  int K, N, t; o.g = nullptr;
  if (j < c1) { t = j; K = 1024; N = 3776; o.src = p.ab_w_in; o.dst = (bft*)(p.ws + OFF_W0t); o.g = p.norm_g; }
  else if (j < c2) { t = j - c1; K = 384; N = 1536; o.src = p.mla_w_q_up; o.dst = (bft*)(p.ws + OFF_Wq); o.g = p.mla_q_norm; }
  else if (j < c3) { t = j - c2; K = 256; N = 2048; o.src = p.mla_w_kv_up; o.dst = (bft*)(p.ws + OFF_Wkv); o.g = p.mla_kv_norm; }
  else if (j < c4) { t = j - c3; K = 1024; N = 1024; o.src = p.s5_glu_w; o.dst = (bft*)(p.ws + OFF_Wglu); }
  else if (j < c5) { t = j - c4; K = 2048; N = 1024; o.src = p.ab_w_out; o.dst = (bft*)(p.ws + OFF_Wout0); }
  else if (j < c6) { t = j - c5; int l = t >> 8; t &= 255; K = 1024; N = 1024; o.src = p.ple_gate_w + (size_t)l * 1024 * 1024; o.dst = (bft*)(p.ws + OFF_Wpg + l * SZ_Wsq); }
  else if (j < c7) { t = j - c6; int l = t >> 6; t &= 63; K = 256; N = 1024; o.src = p.ple_w + (size_t)l * 256 * 1024; o.dst = (bft*)(p.ws + OFF_Wpw + l * SZ_Wpw); }
  else if (j < c8) { t = j - c7; K = 1024; N = 8192; o.src = p.hy_w_in; o.dst = (bft*)(p.ws + OFF_W1t); o.g = p.norm_g + 1024; }
  else if (j < c9) { t = j - c8; K = 2048; N = 1024; o.src = p.hy_w_out; o.dst = (bft*)(p.ws + OFF_Wout1); }
  else return false;
  int nt = N / 64; int kt = t / nt, ntile = t % nt;
  o.ldsrc = N; o.srccol0 = ntile * 64; o.k0 = kt * 64; o.lddst = K + 64; o.dstrow0 = ntile * 64;
  if (j >= c7 && j < c8) { int n0 = ntile * 64, part = n0 >> 11, rem = n0 & 2047, ch = rem >> 8, cc0 = rem & 255; o.dstrow0 = ch * 1024 + part * 256 + cc0; }
  return true;
}
constexpr int N_TRJOBS = 944 + 144 + 128 + 256 + 512 + 512 + 128 + 2048 + 512;

DI void phase_prep(const Params& p) {
  int tix_ = threadIdx.x; asm volatile("" : "+v"(tix_));
  const int tid = tix_, lane = tid & 63, wid = tid >> 6;
  float* tile = (float*)smem;
  for (int j = blockIdx.x; j < N_TRJOBS; j += gridDim.x) {
    TrJob jb; get_trjob(p, j, jb);
    { int r = tid >> 6, c = tid & 63;
      for (int i = 0; i < 8; ++i) { int k = i * 8 + r; float v = jb.src[(size_t)(jb.k0 + k) * jb.ldsrc + jb.srccol0 + c]; if (jb.g) v *= jb.g[jb.k0 + k]; tile[k * 65 + c] = v; } }
    __syncthreads();
    { int n = tid >> 3, kq = tid & 7; u32x4 w;
      w[0] = pack2(tile[(kq * 8 + 0) * 65 + n], tile[(kq * 8 + 1) * 65 + n]); w[1] = pack2(tile[(kq * 8 + 2) * 65 + n], tile[(kq * 8 + 3) * 65 + n]);
      w[2] = pack2(tile[(kq * 8 + 4) * 65 + n], tile[(kq * 8 + 5) * 65 + n]); w[3] = pack2(tile[(kq * 8 + 6) * 65 + n], tile[(kq * 8 + 7) * 65 + n]);
      *(u32x4*)(jb.dst + (size_t)(jb.dstrow0 + n) * jb.lddst + jb.k0 + kq * 8) = w; }
    __syncthreads();
  }
  bft* xb = (bft*)(p.ws + OFF_A); float* r0 = (float*)(p.ws + OFF_R0);
  for (int it = blockIdx.x; it < T / 8; it += gridDim.x) {
    int tok = it * 8 + wid; const float* xr = xrow(p, tok); float ss = 0;
    for (int i = 0; i < 4; ++i) { f32x4 v = *(const f32x4*)(xr + i * 256 + lane * 4); ss += v[0] * v[0] + v[1] * v[1] + v[2] * v[2] + v[3] * v[3];
      u32x2 w = {pack2(v[0], v[1]), pack2(v[2], v[3])}; *(u32x2*)(xb + (size_t)tok * LDP + i * 256 + lane * 4) = w; }
    ss = wave_sum(ss); if (lane == 0) r0[tok] = rsqrtf(ss * (1.f / 1024) + EPS);
  }
  const long gsz = (long)gridDim.x * NTHR, gid = (long)blockIdx.x * NTHR + tid;
  { float* z = (float*)(p.ws + OFF_SSQ1); for (long i = gid; i < 2 * T; i += gsz) z[i] = 0.f; }
  { float* rt = (float*)(p.ws + OFF_ROPE); for (long i = gid; i < 8192 * 32; i += gsz) { int pos = (int)(i >> 5), k = (int)(i & 31); float s, c; sincos_d((double)pos * p.rope_inv[k], s, c); rt[pos * 64 + k] = c; rt[pos * 64 + 32 + k] = s; } }
  { float* h2t = (float*)(p.ws + OFF_H2);
    for (int it = blockIdx.x * 8 + wid; it < (8192 + 4096) * 2 / 4; it += gridDim.x * 8) {
      const int i4 = it * 4; int Lsel = i4 < 16384 ? 0 : 1; int r = Lsel ? i4 - 16384 : i4; int L = Lsel ? 4096 : 8192; int dir = r / L, l0 = r % L;
      float zv[4];
#pragma unroll
      for (int k = 0; k < 4; ++k) { const int l = l0 + k; float tl = (float)l / (float)(L - 1); double w = 6.283185307179586 * (double)l / (double)L; float z = 0.f;
        if (lane == 0) z = tl;
        else if (lane <= 32) { int jj = (lane - 1) & 15; double band = 1e-4 + (double)jj * ((15.0 - 1e-4) / 15.0); float s, c; sincos_d(band * w, s, c); z = lane <= 16 ? c : -s; }
        zv[k] = z; }
      const float* w1 = p.hy_f_w1 + (size_t)dir * 33 * 64; const float b1v = p.hy_f_b1[dir * 64 + lane]; float a[4] = {b1v, b1v, b1v, b1v};
      for (int i = 0; i < 33; ++i) { const float wv = w1[i * 64 + lane];
#pragma unroll
        for (int k = 0; k < 4; ++k) a[k] += __shfl(zv[k], i) * wv; }
      const float f1 = p.hy_f_freq1[dir * 64 + lane]; float h1[4];
#pragma unroll
      for (int k = 0; k < 4; ++k) h1[k] = sin_f(f1 * a[k]);
      const float* w2 = p.hy_f_w2 + (size_t)dir * 64 * 64; const float b2v = p.hy_f_b2[dir * 64 + lane]; float bb[4] = {b2v, b2v, b2v, b2v};
      for (int i = 0; i < 64; ++i) { const float wv = w2[i * 64 + lane];
#pragma unroll
        for (int k = 0; k < 4; ++k) bb[k] += __shfl(h1[k], i) * wv; }
      const float f2 = p.hy_f_freq2[dir * 64 + lane]; f32x4 o;
#pragma unroll
      for (int k = 0; k < 4; ++k) o[k] = sin_f(f2 * bb[k]);
      size_t base = Lsel ? (size_t)8192 * 2 * 64 : 0; *(f32x4*)(h2t + base + ((size_t)dir * 64 + lane) * L + l0) = o;
    } }
}

struct APlain { const bft* A; int lda; int brow; DI const bft* operator()(int row, int kt, int ch) const { return A + (size_t)(brow + row) * lda + kt * 64 + ch * 8; } };
template <class AF>
DI void gemm_stage(int tid, const AF& af, const bft* Bt, int ldb, int bcol, int kt, char* sA, char* sB) {
#pragma unroll
  for (int i = 0; i < 4; ++i) { int slot = tid + i * 512, row = slot >> 3, ch = (slot & 7) ^ (row & 7);
    __builtin_amdgcn_global_load_lds((const unsigned*)af(row, kt, ch), (unsigned*)(sA + slot * 16), 16, 0, 0); }
#pragma unroll
  for (int i = 0; i < 2; ++i) { int slot = tid + i * 512, row = slot >> 3, ch = (slot & 7) ^ (row & 7);
    __builtin_amdgcn_global_load_lds((const unsigned*)(Bt + (size_t)(bcol + row) * ldb + kt * 64 + ch * 8), (unsigned*)(sB + slot * 16), 16, 0, 0); }
}
DI void gemm_compute(int tid, const char* sA, const char* sB, f32x4 (&acc)[4][4]) {
  const int wid = tid >> 6, lane = tid & 63, wr = wid >> 1, wc = wid & 1, fr = lane & 15, fq = lane >> 4;
#pragma unroll
  for (int kk = 0; kk < 2; ++kk) {
    bf16x8 a[4], b[4];
#pragma unroll
    for (int m = 0; m < 4; ++m) { int row = wr * 64 + m * 16 + fr; a[m] = *(const bf16x8*)(sA + row * 128 + (((kk * 4 + fq) ^ (row & 7)) << 4)); }
#pragma unroll
    for (int n = 0; n < 4; ++n) { int row = wc * 64 + n * 16 + fr; b[n] = *(const bf16x8*)(sB + row * 128 + (((kk * 4 + fq) ^ (row & 7)) << 4)); }
#pragma unroll
    for (int m = 0; m < 4; ++m)
#pragma unroll
      for (int n = 0; n < 4; ++n) acc[m][n] = __builtin_amdgcn_mfma_f32_16x16x32_bf16(a[m], b[n], acc[m][n], 0, 0, 0);
  }
}
template <class AF>
DI void gemm_mainloop_t(int tid, const AF& af, const bft* Bt, int ldb, int bcol, int K, f32x4 (&acc)[4][4]) {
  const int nk = K >> 6;
  gemm_stage(tid, af, Bt, ldb, bcol, 0, smem, smem + 32768);
  if (nk > 1) gemm_stage(tid, af, Bt, ldb, bcol, 1, smem + 49152, smem + 49152 + 32768);
  int cb = 0;
#pragma unroll 1
  for (int kt = 0; kt < nk; ++kt) {
    if (kt + 1 < nk) asm volatile("s_waitcnt vmcnt(6)" ::: "memory"); else asm volatile("s_waitcnt vmcnt(0)" ::: "memory");
    __syncthreads();
    if (kt + 2 < nk) { int nb = cb + 2; if (nb >= 3) nb -= 3; char* nxt = smem + nb * 49152; gemm_stage(tid, af, Bt, ldb, bcol, kt + 2, nxt, nxt + 32768); }
    char* cur = smem + cb * 49152;
    gemm_compute(tid, cur, cur + 32768, acc);
    if (++cb == 3) cb = 0;
  }
  __syncthreads();
}
DI void gemm_mainloop(int tid, const bft* A, int lda, const bft* Bt, int ldb, int brow, int bcol, int K, f32x4 (&acc)[4][4]) {
  APlain af{A, lda, brow}; gemm_mainloop_t(tid, af, Bt, ldb, bcol, K, acc);
}
template <class AF>
DI void g256_stage(int tid, const AF& af, const bft* Bt, int ldb, int bcol, int kt, char* sA, char* sB) {
#pragma unroll
  for (int i = 0; i < 4; ++i) { int slot = tid + i * 512, row = slot >> 3, ch = (slot & 7) ^ (row & 7);
    __builtin_amdgcn_global_load_lds((const unsigned*)af(row, kt, ch), (unsigned*)(sA + slot * 16), 16, 0, 0); }
#pragma unroll
  for (int i = 0; i < 4; ++i) { int slot = tid + i * 512, row = slot >> 3, ch = (slot & 7) ^ (row & 7);
    __builtin_amdgcn_global_load_lds((const unsigned*)(Bt + (size_t)(bcol + row) * ldb + kt * 64 + ch * 8), (unsigned*)(sB + slot * 16), 16, 0, 0); }
}
template <int KK0, int KK1>
DI void g256_compute(int tid, const char* sA, const char* sB, f32x4 (&acc)[8][4]) {
  const int wid = tid >> 6, lane = tid & 63, wr = wid >> 2, wc = wid & 3, fr = lane & 15, fq = lane >> 4;
#pragma unroll
  for (int kk = KK0; kk < KK1; ++kk) {
    bf16x8 b[4], a[4], a2[4];
#pragma unroll
    for (int n = 0; n < 4; ++n) { int row = wc * 64 + n * 16 + fr; b[n] = *(const bf16x8*)(sB + row * 128 + (((kk * 4 + fq) ^ (row & 7)) << 4)); }
#pragma unroll
    for (int m = 0; m < 4; ++m) { int row = wr * 128 + m * 16 + fr; a[m] = *(const bf16x8*)(sA + row * 128 + (((kk * 4 + fq) ^ (row & 7)) << 4)); }
    __builtin_amdgcn_sched_barrier(0);
#pragma unroll
    for (int m = 0; m < 4; ++m) { int row = wr * 128 + (4 + m) * 16 + fr; a2[m] = *(const bf16x8*)(sA + row * 128 + (((kk * 4 + fq) ^ (row & 7)) << 4)); }
    __builtin_amdgcn_s_setprio(1);
#pragma unroll
    for (int m = 0; m < 4; ++m)
#pragma unroll
      for (int n = 0; n < 4; ++n) acc[m][n] = __builtin_amdgcn_mfma_f32_16x16x32_bf16(a[m], b[n], acc[m][n], 0, 0, 0);
    __builtin_amdgcn_sched_barrier(0);
#pragma unroll
    for (int m = 0; m < 4; ++m)
#pragma unroll
      for (int n = 0; n < 4; ++n) acc[4 + m][n] = __builtin_amdgcn_mfma_f32_16x16x32_bf16(a2[m], b[n], acc[4 + m][n], 0, 0, 0);
    __builtin_amdgcn_s_setprio(0);
    __builtin_amdgcn_sched_barrier(0);
  }
}
template <class AF>
DI void g256_mainloop_t(int tid, const AF& af, const bft* Bt, int ldb, int bcol, int K, f32x4 (&acc)[8][4]) {
  const int nk = K >> 6;
  g256_stage(tid, af, Bt, ldb, bcol, 0, smem, smem + 32768);
#pragma unroll 1
  for (int kt = 0; kt < nk; ++kt) {
    asm volatile("s_waitcnt vmcnt(0)" ::: "memory");
    __syncthreads();
    char* cur = smem + (kt & 1) * 65536; char* nxt = smem + ((kt + 1) & 1) * 65536;
    if (tid < 256) {
      if (kt + 1 < nk) g256_stage(tid, af, Bt, ldb, bcol, kt + 1, nxt, nxt + 32768);
      g256_compute<0, 2>(tid, cur, cur + 32768, acc);
    } else {
      g256_compute<0, 1>(tid, cur, cur + 32768, acc);
      if (kt + 1 < nk) g256_stage(tid, af, Bt, ldb, bcol, kt + 1, nxt, nxt + 32768);
      g256_compute<1, 2>(tid, cur, cur + 32768, acc);
    }
  }
  __syncthreads();
}
DI void g256_mainloop(int tid, const bft* A, int lda, const bft* Bt, int ldb, int brow, int bcol, int K, f32x4 (&acc)[8][4]) {
  APlain af{A, lda, brow}; g256_mainloop_t(tid, af, Bt, ldb, bcol, K, acc);
}
#define ACC256_ZERO(acc) for (int m_ = 0; m_ < 8; ++m_) for (int n_ = 0; n_ < 4; ++n_) acc[m_][n_] = f32x4{0.f, 0.f, 0.f, 0.f}
#define ACC_ZERO(acc) for (int m_ = 0; m_ < 4; ++m_) for (int n_ = 0; n_ < 4; ++n_) acc[m_][n_] = f32x4{0.f, 0.f, 0.f, 0.f}
template <int PATCH = 98304> DI void epi_stage(int tid, const f32x4 (&am)[4], float (&v)[16]) {
  const int lane = tid & 63, wid = tid >> 6, fr = lane & 15, fq = lane >> 4;
  float* stg = (float*)(smem + PATCH) + wid * (16 * 68);
  asm volatile("" ::: "memory");
#pragma unroll
  for (int n = 0; n < 4; ++n)
#pragma unroll
    for (int j = 0; j < 4; ++j) stg[(fq * 4 + j) * 68 + n * 16 + fr] = am[n][j];
  asm volatile("s_waitcnt lgkmcnt(0)" ::: "memory");
  const float* rp = stg + (lane >> 2) * 68 + (lane & 3) * 16;
#pragma unroll
  for (int i = 0; i < 4; ++i) { f32x4 t = *(const f32x4*)(rp + i * 4); v[4 * i] = t[0]; v[4 * i + 1] = t[1]; v[4 * i + 2] = t[2]; v[4 * i + 3] = t[3]; }
  asm volatile("" ::: "memory");
}
DI void store16_bf(bft* dst, const float (&v)[16]) {
  u32x4 o0 = {pack2(v[0], v[1]), pack2(v[2], v[3]), pack2(v[4], v[5]), pack2(v[6], v[7])}, o1 = {pack2(v[8], v[9]), pack2(v[10], v[11]), pack2(v[12], v[13]), pack2(v[14], v[15])};
  *(u32x4*)dst = o0; *(u32x4*)(dst + 8) = o1;
}
DI void load16_bf(const bft* src, float (&v)[16]) {
  u32x4 w0 = *(const u32x4*)src, w1 = *(const u32x4*)(src + 8);
#pragma unroll
  for (int i = 0; i < 4; ++i) { v[2 * i] = __uint_as_float(w0[i] << 16); v[2 * i + 1] = __uint_as_float(w0[i] & 0xffff0000u); v[8 + 2 * i] = __uint_as_float(w1[i] << 16); v[8 + 2 * i + 1] = __uint_as_float(w1[i] & 0xffff0000u); }
}
DI void load16_f(const float* src, float (&v)[16]) {
#pragma unroll
  for (int i = 0; i < 4; ++i) { f32x4 t = *(const f32x4*)(src + 4 * i); v[4 * i] = t[0]; v[4 * i + 1] = t[1]; v[4 * i + 2] = t[2]; v[4 * i + 3] = t[3]; }
}
DI void store16_f(float* dst, const float (&v)[16]) {
#pragma unroll
  for (int i = 0; i < 4; ++i) { f32x4 t = {v[4 * i], v[4 * i + 1], v[4 * i + 2], v[4 * i + 3]}; *(f32x4*)(dst + 4 * i) = t; }
}
#define EPI_BEGIN const int wid = tid >> 6, lane = tid & 63, wr = wid >> 1, wc = wid & 1; \
  _Pragma("unroll") for (int m = 0; m < 4; ++m) { float v[16]; epi_stage(tid, acc[m], v); const int row = brow + wr * 64 + m * 16 + (lane >> 2), col = bcol + wc * 64 + (lane & 3) * 16; (void)row; (void)col;
#define EPI_END }
#define EPI256_BEGIN const int wid = tid >> 6, lane = tid & 63, wr = wid >> 2, wc = wid & 3; \
  _Pragma("unroll") for (int m = 0; m < 8; ++m) { float v[16]; epi_stage<65536>(tid, acc[m], v); const int row = brow + wr * 128 + m * 16 + (lane >> 2), col = bcol + wc * 64 + (lane & 3) * 16; (void)row; (void)col;

DI void phase_inproj0(const Params& p) {
  int tix_ = threadIdx.x; asm volatile("" : "+v"(tix_));
  const bft* A = (const bft*)(p.ws + OFF_A); const bft* Bt = (const bft*)(p.ws + OFF_W0t); const float* r0 = (const float*)(p.ws + OFF_R0);
  bft* u = (bft*)(p.ws + OFF_U); bft* lat = (bft*)(p.ws + OFF_LAT); bft* G0 = (bft*)(p.ws + OFF_G0);
  const int NT = 15, MT = T / 256;
  for (int r_ = 0, it; xcd_item(r_, NT, MT, it); ++r_) {
    int brow = (it / NT) * 256, bcol = (it % NT) * 256;
    int tid = tix_; asm volatile("" : "+v"(tid));
    f32x4 acc[8][4]; ACC256_ZERO(acc);
    g256_mainloop(tid, A, LDP, Bt, LDW1, brow, bcol, 1024, acc);
    EPI256_BEGIN
      float rs = r0[row];
#pragma unroll
      for (int i = 0; i < 16; ++i) v[i] *= rs;
      if (col < 1024) store16_bf(u + (size_t)row * 1024 + col, v);
      else if (col < 1728) store16_bf(lat + (size_t)row * 704 + col - 1024, v);
      else if (col < 3776) {
#pragma unroll
        for (int i = 0; i < 16; ++i) v[i] = siluf(v[i]);
        store16_bf(G0 + (size_t)row * 2048 + col - 1728, v); }
    EPI_END
  }
}

DI void phase_mlaprep(const Params& p) {
  int tix_ = threadIdx.x; asm volatile("" : "+v"(tix_));
  const int lane = tix_ & 63, wid = tix_ >> 6;
  bft* lat = (bft*)(p.ws + OFF_LAT); const float* rt = (const float*)(p.ws + OFF_ROPE);
  for (int it = blockIdx.x; it < T / 8; it += gridDim.x) {
    int tok = it * 8 + wid; bft* r = lat + (size_t)tok * 704;
    float q[6], kv[4], ss = 0, ss2 = 0;
    for (int i = 0; i < 6; ++i) { q[i] = bf2f(r[lane + 64 * i]); ss += q[i] * q[i]; }
    for (int i = 0; i < 4; ++i) { kv[i] = bf2f(r[384 + lane + 64 * i]); ss2 += kv[i] * kv[i]; }
    float kr = bf2f(r[640 + lane]);
    ss = wave_sum(ss); ss2 = wave_sum(ss2);
    float rq = rsqrtf(ss * (1.f / 384) + EPS), rkv = rsqrtf(ss2 * (1.f / 256) + EPS);
    for (int i = 0; i < 6; ++i) r[lane + 64 * i] = f2bf(q[i] * rq);
    for (int i = 0; i < 4; ++i) r[384 + lane + 64 * i] = f2bf(kv[i] * rkv);
    int pos = tok_pos(tok); float c = rt[pos * 64 + (lane & 31)], s = rt[pos * 64 + 32 + (lane & 31)];
    float xo = __shfl_xor(kr, 32);
    float o = lane < 32 ? kr * c - xo * s : xo * s + kr * c;
    r[640 + lane] = f2bf(o);
  }
}

constexpr int S5Q = 32, S5NC = T / S5Q;
constexpr size_t S5_OFF_S = 0, S5_OFF_X = (size_t)64 * S5NC * 256 * 4, S5_OFF_TM = S5_OFF_X + (size_t)64 * S5NC * 256 * 2;
DI void s5_lam(const Params& p, int dir, int g, int m, float tau, float& pr, float& pi) {
  int idx = (dir * 64 + g) * 64 + m; float are = p.s5_a_re[idx], aim = p.s5_a_im[idx], dt = __expf(p.s5_log_dt[dir * 64 + g]);
  float mag = __expf(are * dt * tau), s, c; sincos_d((double)aim * (double)dt * (double)tau, s, c); pr = mag * c; pi = mag * s;
}
DI void phase_s5gen(const Params& p) {
  int tix_ = threadIdx.x; asm volatile("" : "+v"(tix_));
  const int tid = tix_;
  float2* pw = (float2*)smem;
  float2* Bb = (float2*)(smem + 33792);
  float2* Cc = (float2*)(smem + 33792 + 16384);
  float* Kt = (float*)(smem + 33792 + 32768);
  bft* Tm = (bft*)((char*)p.out + S5_OFF_TM); bft* W1 = (bft*)(p.ws + OFF_A);
  for (int it = blockIdx.x; it < 256; it += gridDim.x) {
    const int g = it >> 2, q4 = it & 3;
    if (tid < 128) { int d = tid >> 6, m = tid & 63; int idx = (d * 64 + g) * 64 + m;
      float are = p.s5_a_re[idx], aim = p.s5_a_im[idx];
      for (int tau = 0; tau <= 32; ++tau) { float pr, pi; s5_lam(p, d, g, m, (float)tau, pr, pi); pw[(d * 33 + tau) * 64 + m] = float2{pr, pi}; }
      float abr, abi; s5_lam(p, d, g, m, 1.f, abr, abi);
      float den = are * are + aim * aim, cr = ((abr - 1.f) * are + abi * aim) / den, ci = (abi * are - (abr - 1.f) * aim) / den;
      for (int c = 0; c < 16; ++c) { float br = p.s5_b_re[(size_t)idx * 16 + c], bi = p.s5_b_im[(size_t)idx * 16 + c]; Bb[(d * 64 + m) * 16 + c] = float2{cr * br - ci * bi, cr * bi + ci * br};
        Cc[(d * 16 + c) * 64 + m] = float2{p.s5_c_re[((size_t)(d * 64 + g) * 16 + c) * 64 + m], p.s5_c_im[((size_t)(d * 64 + g) * 16 + c) * 64 + m]}; } }
    __syncthreads();
    for (int e = tid; e < 1024; e += NTHR) {
      const int d = e >> 9, tau = (e >> 4) & 31, cb = ((e >> 2) & 3) * 4, c2b = (e & 3) * 4; float acc[4][4];
#pragma unroll
      for (int i = 0; i < 4; ++i)
#pragma unroll
        for (int j = 0; j < 4; ++j) acc[i][j] = 0.f;
      for (int m = 0; m < 64; ++m) { const float2 pwv = pw[(d * 33 + tau) * 64 + m]; float2 P[4], B[4];
#pragma unroll
        for (int i = 0; i < 4; ++i) { P[i] = cmul(Cc[(d * 16 + cb + i) * 64 + m], pwv); B[i] = Bb[(d * 64 + m) * 16 + c2b + i]; }
#pragma unroll
        for (int i = 0; i < 4; ++i)
#pragma unroll
          for (int j = 0; j < 4; ++j) acc[i][j] += P[i].x * B[j].x - P[i].y * B[j].y; }
#pragma unroll
      for (int i = 0; i < 4; ++i)
#pragma unroll
        for (int j = 0; j < 4; ++j) Kt[((d * 32 + tau) * 16 + cb + i) * 16 + c2b + j] = acc[i][j]; }
    __syncthreads();
    for (int e = tid; e < 128 * 96; e += NTHR) { int n = q4 * 128 + e / 96, k8 = e % 96; int to = n >> 4, c = n & 15; float v[8];
      if (k8 < 64) { int ti = k8 >> 1, c0 = (k8 & 1) * 8;
#pragma unroll
        for (int j = 0; j < 8; ++j) { int c2 = c0 + j; float x;
          if (to > ti) x = Kt[((0 * 32 + (to - ti)) * 16 + c) * 16 + c2]; else if (to < ti) x = Kt[((1 * 32 + (ti - to)) * 16 + c) * 16 + c2];
          else { x = Kt[(c) * 16 + c2] + Kt[((32) * 16 + c) * 16 + c2]; if (c == c2) x += p.s5_d[g * 16 + c]; }
          v[j] = x; } }
      else {
#pragma unroll
        for (int j = 0; j < 8; ++j) { int kk = k8 * 8 - 512 + j; int d = kk >> 7, ri = (kk >> 6) & 1, m = kk & 63; int pwr = d == 0 ? to + 1 : 32 - to;
          float2 P = cmul(Cc[(d * 16 + c) * 64 + m], pw[(d * 33 + pwr) * 64 + m]); v[j] = ri == 0 ? P.x : -P.y; } }
      u32x4 w = {pack2(v[0], v[1]), pack2(v[2], v[3]), pack2(v[4], v[5]), pack2(v[6], v[7])};
      *(u32x4*)(Tm + ((size_t)g * 512 + n) * 768 + k8 * 8) = w; }
    for (int e = tid; e < 64 * 64; e += NTHR) { int n = q4 * 64 + (e >> 6), k8 = e & 63; int d = n >> 7, ri = (n >> 6) & 1, m = n & 63; float v[8];
#pragma unroll
      for (int j = 0; j < 8; ++j) { int k = k8 * 8 + j, tau = k >> 4, c2 = k & 15; int pwr = d == 0 ? 31 - tau : tau;
        float2 V = cmul(pw[(d * 33 + pwr) * 64 + m], Bb[(d * 64 + m) * 16 + c2]); v[j] = ri == 0 ? V.x : V.y; }
      u32x4 w = {pack2(v[0], v[1]), pack2(v[2], v[3]), pack2(v[4], v[5]), pack2(v[6], v[7])};
      *(u32x4*)(W1 + ((size_t)g * 256 + n) * 512 + k8 * 8) = w; }
    __syncthreads();
  }
}
struct AS5 { const bft* u; const bft* X; int g, mrow0; bool withX;
  DI const bft* operator()(int row, int kt, int ch) const {
    if (kt < 8) return u + ((size_t)((mrow0 + row) * 32 + kt * 4 + (ch >> 1)) * 1024 + g * 16 + (ch & 1) * 8);
    return X + ((size_t)(g * S5NC + mrow0 + row) * 256 + (kt - 8) * 64 + ch * 8); } };
DI void phase_s5step1(const Params& p) {
  int tix_ = threadIdx.x; asm volatile("" : "+v"(tix_));
  const bft* u = (const bft*)(p.ws + OFF_U); const bft* W1 = (const bft*)(p.ws + OFF_A); float* S = (float*)((char*)p.out + S5_OFF_S);
  for (int r_ = 0, it; xcd_item(r_, 6, 64, it); ++r_) {
    int g = it / 6, mt = it % 6; const int brow = mt * 256, bcol = 0;
    int tid = tix_; asm volatile("" : "+v"(tid));
    f32x4 acc[8][4]; ACC256_ZERO(acc);
    AS5 af{u, nullptr, g, brow, false};
    g256_mainloop_t(tid, af, W1 + (size_t)g * 256 * 512, 512, bcol, 512, acc);
    EPI256_BEGIN
      store16_f(S + ((size_t)g * S5NC + row) * 256 + col, v);
    EPI_END
  }
}
DI void phase_s5scan(const Params& p) {
  int tix_ = threadIdx.x; asm volatile("" : "+v"(tix_));
  const int lane = tix_ & 63, wid = tix_ >> 6;
  const float* S = (const float*)((char*)p.out + S5_OFF_S); bft* X = (bft*)((char*)p.out + S5_OFF_X);
  for (int wi = blockIdx.x * 8 + wid; wi < 1280; wi += gridDim.x * 8) {
    int dir = wi & 1, g = (wi >> 1) & 63, s = wi >> 7;
    int L = s < 2 ? 8192 : 4096; int tok0 = s < 2 ? s * 8192 : TP + (s - 2) * 4096; int nch = L / S5Q, kc0 = tok0 / S5Q;
    float aqr, aqi; s5_lam(p, dir, g, lane, (float)S5Q, aqr, aqi);
    float xr = 0.f, xi = 0.f;
    for (int kb = 0; kb < nch; kb += 8) {
      float sr[8], si[8];
#pragma unroll
      for (int i = 0; i < 8; ++i) { int k = dir ? nch - 1 - (kb + i) : kb + i; const float* sp = S + ((size_t)g * S5NC + kc0 + k) * 256 + dir * 128 + lane; sr[i] = sp[0]; si[i] = sp[64]; }
#pragma unroll
      for (int i = 0; i < 8; ++i) { int k = dir ? nch - 1 - (kb + i) : kb + i; bft* xp = X + ((size_t)g * S5NC + kc0 + k) * 256 + dir * 128 + lane;
        xp[0] = f2bf(xr); xp[64] = f2bf(xi);
        float nr = aqr * xr - aqi * xi + sr[i], ni = aqr * xi + aqi * xr + si[i]; xr = nr; xi = ni; }
    }
  }
}
DI void phase_s5step3(const Params& p) {
  int tix_ = threadIdx.x; asm volatile("" : "+v"(tix_));
  const bft* u = (const bft*)(p.ws + OFF_U); const bft* X = (const bft*)((char*)p.out + S5_OFF_X); const bft* Tm = (const bft*)((char*)p.out + S5_OFF_TM);
  bft* ys = (bft*)(p.ws + OFF_A);
  for (int r_ = 0, it; xcd_item(r_, 12, 64, it); ++r_) {
    int g = it / 12, r = it % 12, mt = r >> 1, nt = r & 1; const int brow = mt * 256, bcol = nt * 256;
    int tid = tix_; asm volatile("" : "+v"(tid));
    f32x4 acc[8][4]; ACC256_ZERO(acc);
    AS5 af{u, X, g, brow, true};
    g256_mainloop_t(tid, af, Tm + (size_t)g * 512 * 768, 768, bcol, 768, acc);
    EPI256_BEGIN
#pragma unroll
      for (int i = 0; i < 16; ++i) v[i] = geluf(v[i]);
      store16_bf(ys + ((size_t)row * 32 + (col >> 4)) * LDP + g * 16, v);
    EPI_END
  }
}

DI void phase_upproj(const Params& p, int sg) {
  int tix_ = threadIdx.x; asm volatile("" : "+v"(tix_));
  const bft* lat = (const bft*)(p.ws + OFF_LAT) + (size_t)sg * 16384 * 704;
  bft* Q = (bft*)p.out; bft* Kb = Q + (size_t)16384 * 1536; bft* Vb = Kb + (size_t)16384 * 1536;
  const float* rt = (const float*)(p.ws + OFF_ROPE);
  const int MT = 64, NQ = 6, NKV = 8;
  for (int r_ = 0, it; xcd_item(r_, NQ + NKV, MT, it); ++r_) {
    const int mt_ = it / (NQ + NKV), nr_ = it % (NQ + NKV);
    int tid = tix_; asm volatile("" : "+v"(tid));
    f32x4 acc[8][4]; ACC256_ZERO(acc);
    if (nr_ < NQ) {
      int brow = mt_ * 256, bcol = nr_ * 256;
      g256_mainloop(tid, lat, 704, (const bft*)(p.ws + OFF_Wq), LDWQ, brow, bcol, 384, acc);
      EPI256_BEGIN
        const int cw = bcol + wc * 64; const bool is_rope = (cw % 192) == 128;
        if (is_rope) { int pos = tok_pos(sg * 16384 + row); const int cg = lane & 3; const float* rp = rt + pos * 64 + (cg & 1) * 16;
#pragma unroll
          for (int i = 0; i < 16; ++i) { float c = rp[i], s = rp[32 + i]; float xo = __shfl_xor(v[i], 2); v[i] = cg < 2 ? v[i] * c - xo * s : xo * s + v[i] * c; } }
        store16_bf(Q + (size_t)row * 1536 + col, v);
      EPI_END
    } else {
      int brow = mt_ * 256, nt = nr_ - NQ, bcol = nt * 256;
      g256_mainloop(tid, lat + 384, 704, (const bft*)(p.ws + OFF_Wkv), LDWS, brow, bcol, 256, acc);
      const int h = nt;
      EPI256_BEGIN
        const int d = col - bcol;
        if (d >= 128) store16_bf(Vb + (size_t)row * 1024 + h * 128 + d - 128, v); else store16_bf(Kb + (size_t)row * 1536 + h * 192 + d, v);
      EPI_END
      { for (int i = tix_; i < 256 * 8; i += 512) { int r = i >> 3, c8 = i & 7;
          *(u32x4*)(Kb + (size_t)(brow + r) * 1536 + h * 192 + 128 + c8 * 8) = *(const u32x4*)(lat + (size_t)(brow + r) * 704 + 640 + c8 * 8); } }
    }
  }
}

constexpr int KVBLK = 64;
constexpr float ATT_SCALE = 0.07216878364870323f;
constexpr float ATT_THR = 8.f;
constexpr int SHM_V = KVBLK * 128 * 2, SHM_K = KVBLK * 400;
#define KSWZ(row, colB) ((row) * 400 + (colB))
#define SBAR() __builtin_amdgcn_sched_barrier(0)
DI int crow(int r, int hi) { return (r & 3) + 8 * (r >> 2) + 4 * hi; }
DI unsigned cvtpk(float lo, float hi) { unsigned r; asm volatile("v_cvt_pk_bf16_f32 %0, %1, %2" : "=v"(r) : "v"(lo), "v"(hi)); return r; }
DI void partialSM(f32x16& p0, f32x16& p1, float& m_reg, float& mn, float& alpha) {
  constexpr float C = ATT_SCALE * 1.4426950408889634f;
  float pmax = p0[0];
#pragma unroll
  for (int r = 1; r < 16; ++r) pmax = fmaxf(pmax, p0[r]);
#pragma unroll
  for (int r = 0; r < 16; ++r) pmax = fmaxf(pmax, p1[r]);
  { auto rr = __builtin_amdgcn_permlane32_swap(__float_as_uint(pmax), __float_as_uint(pmax), false, false);
    pmax = fmaxf(__uint_as_float(rr[0]), __uint_as_float(rr[1])); }
  if (__builtin_expect(__all(pmax - m_reg <= ATT_THR / ATT_SCALE), 1)) { mn = m_reg; alpha = 1.f; }
  else { mn = fmaxf(m_reg, pmax); alpha = __builtin_amdgcn_exp2f((m_reg - mn) * C); m_reg = mn; }
  float mnC = -mn * C;
#pragma unroll
  for (int r = 0; r < 16; ++r) p0[r] = fmaf(p0[r], C, mnC);
#pragma unroll
  for (int r = 0; r < 16; ++r) p1[r] = fmaf(p1[r], C, mnC);
#pragma unroll
  for (int r = 0; r < 16; ++r) p0[r] = __builtin_amdgcn_exp2f(p0[r]);
}
DI void finishSM(f32x16& p0, f32x16& p1, float alpha, float& l_reg, bf16x8& pa0, bf16x8& pa1, bf16x8& pa2, bf16x8& pa3) {
#pragma unroll
  for (int r = 0; r < 16; ++r) p1[r] = __builtin_amdgcn_exp2f(p1[r]);
  float ps = 0;
#pragma unroll
  for (int r = 0; r < 16; ++r) ps += p0[r];
#pragma unroll
  for (int r = 0; r < 16; ++r) ps += p1[r];
  { auto rr = __builtin_amdgcn_permlane32_swap(__float_as_uint(ps), __float_as_uint(ps), false, false);
    ps = __uint_as_float(rr[0]) + __uint_as_float(rr[1]); }
  l_reg = l_reg * alpha + ps;
#define PK4(P, BASE, OUT) do { unsigned a0 = cvtpk(P[BASE + 0], P[BASE + 1]), a1 = cvtpk(P[BASE + 2], P[BASE + 3]);   \
    unsigned b0 = cvtpk(P[BASE + 4], P[BASE + 5]), b1 = cvtpk(P[BASE + 6], P[BASE + 7]);                              \
    auto r0 = __builtin_amdgcn_permlane32_swap(a0, b0, false, false); auto r1 = __builtin_amdgcn_permlane32_swap(a1, b1, false, false); \
    u32x4 w = {r0[0], r1[0], r0[1], r1[1]}; OUT = *reinterpret_cast<bf16x8*>(&w); } while (0)
  PK4(p0, 0, pa0); PK4(p0, 8, pa1); PK4(p1, 0, pa2); PK4(p1, 8, pa3);
#undef PK4
}
DI void qkt(f32x16& p0, f32x16& p1, const char* Ks, const bf16x8* qr, int r32, int hi) {
  p0 = f32x16{}; p1 = f32x16{};
#pragma unroll
  for (int d0 = 0; d0 < 12; ++d0) { int cb = (d0 * 16 + hi * 8) * 2;
    bf16x8 b0 = *reinterpret_cast<const bf16x8*>(Ks + KSWZ(r32, cb));
    bf16x8 b1 = *reinterpret_cast<const bf16x8*>(Ks + KSWZ(32 + r32, cb));
    p0 = __builtin_amdgcn_mfma_f32_32x32x16_bf16(b0, qr[d0], p0, 0, 0, 0);
    p1 = __builtin_amdgcn_mfma_f32_32x32x16_bf16(b1, qr[d0], p1, 0, 0, 0); }
}
DI int v_st(int k, int c) { const int kk = (k & ~0xC) | ((k & 4) << 1) | ((k & 8) >> 1); return ((kk >> 3) * 4 + (c >> 5)) * 512 + ((kk & 7) * 32 + (c & 31)) * 2; }
DI int v_rd_base(int lane) { return ((lane & 3) << 3) | (((lane >> 2) & 3) << 6) | (((lane >> 4) & 1) << 5) | (((lane >> 5) & 1) << 8); }
constexpr int v_rd_off(int d0, int ks, int half) { return d0 * 512 + ks * 4096 + half * 2048; }
template <int OFF> DI s16x4 tr_read(int vb) { s16x4 r; asm volatile("ds_read_b64_tr_b16 %0, %1 offset:%2" : "=&v"(r) : "v"(vb), "i"(OFF) : "memory"); return r; }
template <int D0> DI void pv_one(f32x16& od, int vb, bf16x8 pa0, bf16x8 pa1, bf16x8 pa2, bf16x8 pa3) {
  const s16x4 l0 = tr_read<v_rd_off(D0, 0, 0)>(vb), h0 = tr_read<v_rd_off(D0, 0, 1)>(vb), l1 = tr_read<v_rd_off(D0, 1, 0)>(vb), h1 = tr_read<v_rd_off(D0, 1, 1)>(vb);
  const s16x4 l2 = tr_read<v_rd_off(D0, 2, 0)>(vb), h2 = tr_read<v_rd_off(D0, 2, 1)>(vb), l3 = tr_read<v_rd_off(D0, 3, 0)>(vb), h3 = tr_read<v_rd_off(D0, 3, 1)>(vb);
  asm volatile("s_waitcnt lgkmcnt(0)" ::: "memory"); SBAR();
#define PK(L, H) (bf16x8){L[0], L[1], L[2], L[3], H[0], H[1], H[2], H[3]}
  od = __builtin_amdgcn_mfma_f32_32x32x16_bf16(pa0, PK(l0, h0), od, 0, 0, 0);
  od = __builtin_amdgcn_mfma_f32_32x32x16_bf16(pa1, PK(l1, h1), od, 0, 0, 0);
  od = __builtin_amdgcn_mfma_f32_32x32x16_bf16(pa2, PK(l2, h2), od, 0, 0, 0);
  od = __builtin_amdgcn_mfma_f32_32x32x16_bf16(pa3, PK(l3, h3), od, 0, 0, 0);
#undef PK
}
DI void pv_d0(f32x16* o, int vb, bf16x8 pa0, bf16x8 pa1, bf16x8 pa2, bf16x8 pa3) {
  pv_one<0>(o[0], vb, pa0, pa1, pa2, pa3); pv_one<1>(o[1], vb, pa0, pa1, pa2, pa3); pv_one<2>(o[2], vb, pa0, pa1, pa2, pa3); pv_one<3>(o[3], vb, pa0, pa1, pa2, pa3);
}
DI void attn_body(const bft* __restrict__ Qb, const bft* __restrict__ Kh, const bft* __restrict__ Vh, bft* __restrict__ Gb, int seq) {
  int tid = threadIdx.x; asm volatile("" : "+v"(tid));
  const int wid = tid >> 6, lane = tid & 63, r32 = lane & 31, hi = lane >> 5;
  char* V_lds = smem; char* K_lds = smem + 2 * SHM_V;
  float* wsl = (float*)(smem + 2 * SHM_V + 2 * SHM_K) + wid * 64; float* li_l = wsl; float* al_l = wsl + 32;
  float m_reg = -1e30f, l_reg = 0; f32x16 o[4] = {}; bf16x8 qr[12];
  const bft* Qw = Qb + (size_t)(wid * 32 + r32) * 1536 + hi * 8;
#pragma unroll
  for (int d0 = 0; d0 < 12; ++d0) qr[d0] = *(const bf16x8*)(Qw + d0 * 16);
  const int sr = tid >> 4, sc = (tid & 15) * 8, vst0 = v_st(sr, sc), vst1 = v_st(32 + sr, sc);
  const int kr0 = tid / 24, kc0 = (tid % 24) * 8, kr1 = (tid + 512) / 24, kc1 = ((tid + 512) % 24) * 8, kr2 = (tid + 1024) / 24, kc2 = ((tid + 1024) % 24) * 8;
  const int vb0 = (int)(uintptr_t)V_lds + v_rd_base(lane);
  bf16x8 vs0, vs1, ks0, ks1, ks2;
#define SLOAD(k0) do { vs0 = *(const bf16x8*)(&Vh[(size_t)((k0) + sr) * 1024 + sc]); vs1 = *(const bf16x8*)(&Vh[(size_t)((k0) + 32 + sr) * 1024 + sc]); \
    ks0 = *(const bf16x8*)(&Kh[(size_t)((k0) + kr0) * 1536 + kc0]); ks1 = *(const bf16x8*)(&Kh[(size_t)((k0) + kr1) * 1536 + kc1]); ks2 = *(const bf16x8*)(&Kh[(size_t)((k0) + kr2) * 1536 + kc2]); } while (0)
#define SWRITE(b) do { *(bf16x8*)(V_lds + (b) * SHM_V + vst0) = vs0; *(bf16x8*)(V_lds + (b) * SHM_V + vst1) = vs1; \
    *(bf16x8*)(K_lds + (b) * SHM_K + KSWZ(kr0, kc0 * 2)) = ks0; *(bf16x8*)(K_lds + (b) * SHM_K + KSWZ(kr1, kc1 * 2)) = ks1; *(bf16x8*)(K_lds + (b) * SHM_K + KSWZ(kr2, kc2 * 2)) = ks2; } while (0)
#define SWAIT() asm volatile("s_waitcnt vmcnt(0)" ::: "memory")
#define RESC(a) do { if (__any((a) < 1.f)) { if (hi == 0) al_l[r32] = (a); asm volatile("s_waitcnt lgkmcnt(0)" ::: "memory"); \
    for (int d = 0; d < 4; ++d) for (int r = 0; r < 16; ++r) o[d][r] *= al_l[crow(r, hi)]; } } while (0)
  f32x16 pA0, pA1; float mnA, alA; bf16x8 pa0, pa1, pa2, pa3; const int NT = seq / KVBLK;
  SLOAD(0); SWAIT(); SWRITE(0); __syncthreads();
  for (int j = 0; j < NT; ++j) {
    const int b = j & 1;
    if (j + 1 < NT) SLOAD((j + 1) * KVBLK);
    SBAR(); qkt(pA0, pA1, K_lds + b * SHM_K, qr, r32, hi);
    partialSM(pA0, pA1, m_reg, mnA, alA);
    RESC(alA);
    finishSM(pA0, pA1, alA, l_reg, pa0, pa1, pa2, pa3); SBAR();
    pv_d0(o, vb0 + b * SHM_V, pa0, pa1, pa2, pa3);
    if (j + 1 < NT) { SWAIT(); SWRITE(b ^ 1); }
    __syncthreads();
  }
  if (hi == 0) li_l[r32] = l_reg; asm volatile("s_waitcnt lgkmcnt(0)" ::: "memory");
  float rli[16];
#pragma unroll
  for (int r = 0; r < 16; ++r) rli[r] = __builtin_amdgcn_rcpf(li_l[crow(r, hi)]);
  bft* Gw = Gb + (size_t)(wid * 32) * 2048;
#pragma unroll
  for (int r = 0; r < 16; ++r) { int orow = crow(r, hi);
#pragma unroll
    for (int d0 = 0; d0 < 4; ++d0) { bft* gp = Gw + (size_t)orow * 2048 + d0 * 32 + r32; *gp = f2bf(o[d0][r] * rli[r] * bf2f(*gp)); } }
  __syncthreads();
#undef SLOAD
#undef SWRITE
#undef SWAIT
#undef RESC
}
DI void phase_attn(const Params& p, int sg) {
  int tix_ = threadIdx.x; asm volatile("" : "+v"(tix_));
  const bft* Q = (const bft*)p.out; const bft* Kb = Q + (size_t)16384 * 1536; const bft* Vb = Kb + (size_t)16384 * 1536;
  bft* G0 = (bft*)(p.ws + OFF_G0) + (size_t)sg * 16384 * 2048;
  const int L = sg == 0 ? 8192 : 4096; const int nqb = L / 256;
  for (int r_ = 0, it; xcd_item(r_, nqb, 512 / nqb, it); ++r_) {
    int qb = it % nqb, rest = it / nqb, h = rest & 7, sl = rest >> 3;
    size_t t0 = (size_t)sl * L;
    attn_body(Q + (t0 + qb * 256) * 1536 + h * 192, Kb + t0 * 1536 + h * 192, Vb + t0 * 1024 + h * 128, G0 + (t0 + qb * 256) * 2048 + 1024 + h * 128, L);
  }
}

DI void convert_p(const Params& p, int layer) {
  int tix_ = threadIdx.x; asm volatile("" : "+v"(tix_));
  bft* pb = (bft*)(p.ws + OFF_LAT);
  const long gsz = (long)gridDim.x * NTHR, gid = (long)blockIdx.x * NTHR + tix_;
  const float* pp = p.p_prompt + (size_t)layer * TP * 256; const float* ps = p.p_sample + (size_t)layer * (T - TP) * 256;
  for (long i = gid; i < (long)T * 256 / 4; i += gsz) { long e = i * 4; f32x4 v = e < (long)TP * 256 ? *(const f32x4*)(pp + e) : *(const f32x4*)(ps + (e - (long)TP * 256));
    u32x2 w = {pack2(v[0], v[1]), pack2(v[2], v[3])}; *(u32x2*)(pb + e) = w; }
}
DI void phase_glu(const Params& p) {
  int tix_ = threadIdx.x; asm volatile("" : "+v"(tix_));
  const bft* ys = (const bft*)(p.ws + OFF_A); bft* G0 = (bft*)(p.ws + OFF_G0);
  for (int r_ = 0, it; xcd_item(r_, 4, T / 256, it); ++r_) {
    int brow = (it >> 2) * 256, bcol = (it & 3) * 256;
    int tid = tix_; asm volatile("" : "+v"(tid));
    f32x4 acc[8][4]; ACC256_ZERO(acc);
    g256_mainloop(tid, ys, LDP, (const bft*)(p.ws + OFF_Wglu), LDW1, brow, bcol, 1024, acc);
    EPI256_BEGIN
      float y[16], g[16], b[16]; load16_bf(ys + (size_t)row * LDP + col, y); bft* gp = G0 + (size_t)row * 2048 + col; load16_bf(gp, g); load16_f(p.s5_glu_b + col, b);
#pragma unroll
      for (int i = 0; i < 16; ++i) v[i] = y[i] * sigm(v[i] + b[i]) * g[i];
      store16_bf(gp, v);
    EPI_END
  }
  convert_p(p, 0);
}

DI void phase_outproj0(const Params& p) {
  int tix_ = threadIdx.x; asm volatile("" : "+v"(tix_));
  const bft* G0 = (const bft*)(p.ws + OFF_G0); bft* hb = (bft*)(p.ws + OFF_U);
  for (int r_ = 0, it; xcd_item(r_, 4, T / 256, it); ++r_) {
    int brow = (it >> 2) * 256, bcol = (it & 3) * 256;
    int tid = tix_; asm volatile("" : "+v"(tid));
    f32x4 acc[8][4]; ACC256_ZERO(acc);
    g256_mainloop(tid, G0, 2048, (const bft*)(p.ws + OFF_Wout0), LDW2, brow, bcol, 2048, acc);
    EPI256_BEGIN
      float x[16]; load16_f(xrow(p, row) + col, x);
#pragma unroll
      for (int i = 0; i < 16; ++i) v[i] += x[i];
      store16_f(p.out + (size_t)row * 1024 + col, v); store16_bf(hb + (size_t)row * 1024 + col, v);
    EPI_END
  }
}

DI void phase_ple(const Params& p, int layer, const bft* hbin, bft* hbout, int ldo, float* ssq) {
  int tix_ = threadIdx.x; asm volatile("" : "+v"(tix_));
  const bft* pb = (const bft*)(p.ws + OFF_LAT);
  for (int r_ = 0, it; xcd_item(r_, 8, T / 256, it); ++r_) {
    int brow = (it >> 3) * 256, bcol = (it & 7) * 128;
    int tid = tix_; asm volatile("" : "+v"(tid));
    f32x4 acc[4][4], acc2[4][4]; ACC_ZERO(acc); ACC_ZERO(acc2);
    gemm_mainloop(tid, hbin, 1024, (const bft*)(p.ws + OFF_Wpg + layer * SZ_Wsq), LDW1, brow, bcol, 1024, acc);
    gemm_mainloop(tid, pb, 256, (const bft*)(p.ws + OFF_Wpw + layer * SZ_Wpw), LDWS, brow, bcol, 256, acc2);
    EPI_BEGIN
      float v2[16]; epi_stage(tid, acc2[m], v2); float h[16]; float* hp = p.out + (size_t)row * 1024 + col; load16_f(hp, h); float ss = 0.f;
#pragma unroll
      for (int i = 0; i < 16; ++i) { h[i] += sigm(v[i]) * v2[i]; ss += h[i] * h[i]; }
      store16_f(hp, h); if (hbout) store16_bf(hbout + (size_t)row * ldo + col, h);
      ss += __shfl_xor(ss, 1); ss += __shfl_xor(ss, 2);
      if ((lane & 3) == 0) atomicAdd(ssq + row, ss);
    EPI_END
  }
}

DI void phase_inproj1(const Params& p, int ch) {
  int tix_ = threadIdx.x; asm volatile("" : "+v"(tix_));
  const bft* hb = (const bft*)(p.ws + OFF_A); bft* Z = (bft*)(p.ws + OFF_U); const float* ssq1 = (const float*)(p.ws + OFF_SSQ1);
  const bft* Bt = (const bft*)(p.ws + OFF_W1t) + (size_t)ch * 1024 * LDW1;
  for (int r_ = 0, it; xcd_item(r_, 4, T / 256, it); ++r_) {
    int brow = (it >> 2) * 256, bcol = (it & 3) * 256;
    int tid = tix_; asm volatile("" : "+v"(tid));
    f32x4 acc[8][4]; ACC256_ZERO(acc);
    g256_mainloop(tid, hb, LDP, Bt, LDW1, brow, bcol, 1024, acc);
    const bool isgate = bcol >= 768;
    EPI256_BEGIN
      float rs = rsqrtf(ssq1[row] * (1.f / 1024) + EPS);
#pragma unroll
      for (int i = 0; i < 16; ++i) { v[i] *= rs; if (isgate) v[i] = siluf(v[i]); }
      store16_bf(Z + (size_t)row * 1024 + col, v);
    EPI_END
  }
}
DI void phase_filter(const Params& p, int ch) {
  int tix_ = threadIdx.x; asm volatile("" : "+v"(tix_));
  const int tid = tix_;
  const float* h2t = (const float*)(p.ws + OFF_H2); float* kraw = (float*)(p.ws + OFF_KRAW);
  const float mind = -3.0701134573253945f, maxd = -15.350567286626973f;
  float* w3s = (float*)smem;
  for (int it = blockIdx.x; it < 192; it += gridDim.x) {
    int Lsel = it < 128 ? 0 : 1; int r = Lsel ? it - 128 : it; int L = Lsel ? 4096 : 8192; int nlb = L / 512;
    int cq = r & 3; r >>= 2; int lb = r % nlb, dir = r / nlb; int l = lb * 512 + tid; int cc0 = cq * 64, c0 = ch * 256 + cc0;
    const float* w3 = p.hy_f_w3 + (size_t)dir * 64 * 2048 + c0;
    for (int e = tid; e < 4096; e += NTHR) w3s[e] = w3[(size_t)(e >> 6) * 2048 + (e & 63)];
    const float* h2 = h2t + (Lsel ? (size_t)8192 * 2 * 64 : 0) + (size_t)dir * 64 * L + l;
    float hv[64];
#pragma unroll
    for (int j = 0; j < 64; ++j) hv[j] = h2[(size_t)j * L];
    __syncthreads();
    float* kr = kraw + (Lsel ? (size_t)16384 * 256 : 0); const int N = 2 * L; const float tl = (float)l / (float)(L - 1);
#pragma unroll 1
    for (int c4 = 0; c4 < 16; ++c4) {
      float a0 = 0.f, a1 = 0.f, a2 = 0.f, a3 = 0.f;
#pragma unroll
      for (int j = 0; j < 64; ++j) { f32x4 w = *(const f32x4*)(w3s + j * 64 + c4 * 4); a0 += hv[j] * w[0]; a1 += hv[j] * w[1]; a2 += hv[j] * w[2]; a3 += hv[j] * w[3]; }
      float av[4] = {a0, a1, a2, a3};
#pragma unroll
      for (int i = 0; i < 4; ++i) { int cl = c4 * 4 + i; float delta = fabsf(mind + (float)(c0 + cl) * ((maxd - mind) / 2047.f)); float k = av[i] * __expf(-tl * delta);
        float* row = kr + (size_t)(cc0 + cl) * N;
        if (dir == 0) row[l] = k; else if (l > 0) row[N - l] = k; else row[L] = 0.f; }
    }
    __syncthreads();
  }
}
DI float conv3_at(const bft* Z, int tok, int pos, int L, int col, float w0, float w1, float w2, float b) {
  float xm = pos > 0 ? bf2f(Z[(size_t)(tok - 1) * 1024 + col]) : 0.f, x0 = bf2f(Z[(size_t)tok * 1024 + col]), xp = pos < L - 1 ? bf2f(Z[(size_t)(tok + 1) * 1024 + col]) : 0.f;
  return xm * w0 + x0 * w1 + xp * w2 + b;
}
DI float2 twid(float r) { return float2{__builtin_amdgcn_cosf(r), -__builtin_amdgcn_sinf(r)}; }
DI void bfly_fwd(float2 a0, float2 a1, float2 a2, float2 a3, float r, float2& o0, float2& o1, float2& o2, float2& o3) {
  float2 t0 = {a0.x + a2.x, a0.y + a2.y}, t1 = {a0.x - a2.x, a0.y - a2.y}, t2 = {a1.x + a3.x, a1.y + a3.y}, t3 = {a1.x - a3.x, a1.y - a3.y};
  float2 b0 = {t0.x + t2.x, t0.y + t2.y}, b2 = {t0.x - t2.x, t0.y - t2.y}, b1 = {t1.x + t3.y, t1.y - t3.x}, b3 = {t1.x - t3.y, t1.y + t3.x};
  float2 w1 = twid(r), w2 = cmul(w1, w1), w3 = cmul(w2, w1);
  o0 = b0; o1 = cmul(b1, w1); o2 = cmul(b2, w2); o3 = cmul(b3, w3);
}
DI void bfly_inv(float2 s0, float2 s1, float2 s2, float2 s3, float r, float2& o0, float2& o1, float2& o2, float2& o3) {
  float2 w1 = twid(r), w2 = cmul(w1, w1), w3 = cmul(w2, w1);
  float2 c0 = s0, c1 = cmulc(s1, w1), c2 = cmulc(s2, w2), c3 = cmulc(s3, w3);
  float2 t0 = {c0.x + c2.x, c0.y + c2.y}, t1 = {c0.x - c2.x, c0.y - c2.y}, t2 = {c1.x + c3.x, c1.y + c3.y}, t3 = {c1.x - c3.x, c1.y - c3.y};
  o0 = float2{t0.x + t2.x, t0.y + t2.y}; o2 = float2{t0.x - t2.x, t0.y - t2.y}; o1 = float2{t1.x - t3.y, t1.y + t3.x}; o3 = float2{t1.x + t3.y, t1.y - t3.x};
}
template <int N, int NBT = 1> DI void fft_level_fwd(float2* z0, int tid, int lq) {
  const int Q = 1 << lq; const float invM = 1.f / (float)(4 << lq);
  for (int bb = tid; bb < NBT * (N / 4); bb += NTHR) { const int b = bb & (N / 4 - 1); float2* z = z0 + (bb / (N / 4)) * N; int j = b & (Q - 1), base = ((b >> lq) << (lq + 2)) + j; float2 o0, o1, o2, o3;
    bfly_fwd(z[base], z[base + Q], z[base + 2 * Q], z[base + 3 * Q], (float)j * invM, o0, o1, o2, o3);
    z[base] = o0; z[base + Q] = o1; z[base + 2 * Q] = o2; z[base + 3 * Q] = o3; }
  __syncthreads();
}
template <int N, int NBT = 1> DI void fft_level_inv(float2* z0, int tid, int lq) {
  const int Q = 1 << lq; const float invM = 1.f / (float)(4 << lq);
  for (int bb = tid; bb < NBT * (N / 4); bb += NTHR) { const int b = bb & (N / 4 - 1); float2* z = z0 + (bb / (N / 4)) * N; int j = b & (Q - 1), base = ((b >> lq) << (lq + 2)) + j; float2 o0, o1, o2, o3;
    bfly_inv(z[base], z[base + Q], z[base + 2 * Q], z[base + 3 * Q], (float)j * invM, o0, o1, o2, o3);
    z[base] = o0; z[base + Q] = o1; z[base + 2 * Q] = o2; z[base + 3 * Q] = o3; }
  __syncthreads();
}
template <int N, int NBT = 1> DI void fft_pair_fwd(float2* z0, int tid, int lq1) {
  const int lq2 = lq1 - 2, Q1 = 1 << lq1, Q2 = 1 << lq2; const float invM1 = 1.f / (float)(4 << lq1), invM2 = 1.f / (float)(4 << lq2);
  for (int gg = tid; gg < NBT * (N / 16); gg += NTHR) { const int g = gg & (N / 16 - 1); float2* z = z0 + (gg / (N / 16)) * N; const int jp = g & (Q2 - 1), base = ((g >> lq2) << (lq2 + 4)) + jp; float2 x[4][4];
#pragma unroll
    for (int q1 = 0; q1 < 4; ++q1)
#pragma unroll
      for (int q2 = 0; q2 < 4; ++q2) x[q1][q2] = z[base + q1 * Q1 + q2 * Q2];
#pragma unroll
    for (int q2 = 0; q2 < 4; ++q2) bfly_fwd(x[0][q2], x[1][q2], x[2][q2], x[3][q2], (float)(jp + q2 * Q2) * invM1, x[0][q2], x[1][q2], x[2][q2], x[3][q2]);
#pragma unroll
    for (int q1 = 0; q1 < 4; ++q1) bfly_fwd(x[q1][0], x[q1][1], x[q1][2], x[q1][3], (float)jp * invM2, x[q1][0], x[q1][1], x[q1][2], x[q1][3]);
#pragma unroll
    for (int q1 = 0; q1 < 4; ++q1)
#pragma unroll
      for (int q2 = 0; q2 < 4; ++q2) z[base + q1 * Q1 + q2 * Q2] = x[q1][q2]; }
  __syncthreads();
}
template <int N, int NBT = 1> DI void fft_pair_inv(float2* z0, int tid, int lq2) {
  const int lq1 = lq2 + 2, Q1 = 1 << lq1, Q2 = 1 << lq2; const float invM1 = 1.f / (float)(4 << lq1), invM2 = 1.f / (float)(4 << lq2);
  for (int gg = tid; gg < NBT * (N / 16); gg += NTHR) { const int g = gg & (N / 16 - 1); float2* z = z0 + (gg / (N / 16)) * N; const int jp = g & (Q2 - 1), base = ((g >> lq2) << (lq2 + 4)) + jp; float2 x[4][4];
#pragma unroll
    for (int q1 = 0; q1 < 4; ++q1)
#pragma unroll
      for (int q2 = 0; q2 < 4; ++q2) x[q1][q2] = z[base + q1 * Q1 + q2 * Q2];
#pragma unroll
    for (int q1 = 0; q1 < 4; ++q1) bfly_inv(x[q1][0], x[q1][1], x[q1][2], x[q1][3], (float)jp * invM2, x[q1][0], x[q1][1], x[q1][2], x[q1][3]);
#pragma unroll
    for (int q2 = 0; q2 < 4; ++q2) bfly_inv(x[0][q2], x[1][q2], x[2][q2], x[3][q2], (float)(jp + q2 * Q2) * invM1, x[0][q2], x[1][q2], x[2][q2], x[3][q2]);
#pragma unroll
    for (int q1 = 0; q1 < 4; ++q1)
#pragma unroll
      for (int q2 = 0; q2 < 4; ++q2) z[base + q1 * Q1 + q2 * Q2] = x[q1][q2]; }
  __syncthreads();
}
template <int N, int NBT = 1> DI void fft_level0_inv_mul(float2* z0, int tid, const float2* kh) {
  for (int bb = tid; bb < NBT * (N / 4); bb += NTHR) { const int b = bb & (N / 4 - 1); float2* z = z0 + (bb / (N / 4)) * N; const int base = b * 4; f32x4 k01 = *(const f32x4*)(kh + base), k23 = *(const f32x4*)(kh + base + 2); float2 o0, o1, o2, o3;
    bfly_inv(cmul(z[base], float2{k01[0], k01[1]}), cmul(z[base + 1], float2{k01[2], k01[3]}), cmul(z[base + 2], float2{k23[0], k23[1]}), cmul(z[base + 3], float2{k23[2], k23[3]}), 0.f, o0, o1, o2, o3);
    z[base] = o0; z[base + 1] = o1; z[base + 2] = o2; z[base + 3] = o3; }
  __syncthreads();
}
template <int LOGN, bool R2DONE = false> DI void fft_fwd(float2* z, int tid) {
  constexpr int N = 1 << LOGN;
  if constexpr (LOGN & 1) {
    if constexpr (!R2DONE) {
      for (int b = tid; b < N / 2; b += NTHR) { float2 a0 = z[b], a1 = z[b + N / 2]; float2 w = twid((float)b * (1.f / N));
        z[b] = float2{a0.x + a1.x, a0.y + a1.y}; z[b + N / 2] = cmul(float2{a0.x - a1.x, a0.y - a1.y}, w); }
      __syncthreads();
    }
    fft_pair_fwd<N>(z, tid, 10); fft_pair_fwd<N>(z, tid, 6); fft_level_fwd<N>(z, tid, 2); fft_level_fwd<N>(z, tid, 0);
  } else {
    if constexpr (!R2DONE) fft_level_fwd<N>(z, tid, 12);
    fft_pair_fwd<N>(z, tid, 10); fft_pair_fwd<N>(z, tid, 6); fft_level_fwd<N>(z, tid, 2); fft_level_fwd<N>(z, tid, 0);
  }
}
template <int LOGN> DI void fft_inv_mul(float2* z, int tid, const float2* kh) {
  constexpr int N = 1 << LOGN;
  fft_level0_inv_mul<N>(z, tid, kh);
  if constexpr (LOGN & 1) { fft_level_inv<N>(z, tid, 2); fft_pair_inv<N>(z, tid, 4); fft_pair_inv<N>(z, tid, 8); }
  else { fft_level_inv<N>(z, tid, 2); fft_pair_inv<N>(z, tid, 4); fft_pair_inv<N>(z, tid, 8); }
}
DI void fft2x13_fwd(float2* z, int tid) { constexpr int N = 8192;
  fft_pair_fwd<N, 2>(z, tid, 10); fft_pair_fwd<N, 2>(z, tid, 6); fft_level_fwd<N, 2>(z, tid, 2); fft_level_fwd<N, 2>(z, tid, 0); }
DI void fft2x13_inv_mul(float2* z, int tid, const float2* kh) { constexpr int N = 8192;
  fft_level0_inv_mul<N, 2>(z, tid, kh); fft_level_inv<N, 2>(z, tid, 2); fft_pair_inv<N, 2>(z, tid, 4); fft_pair_inv<N, 2>(z, tid, 8); }
template <int LOGN> DI void filtfft_item(const Params& p, int ch, int cc, const float* kr, float2* kh) {
  constexpr int N = 1 << LOGN; int tid = threadIdx.x; asm volatile("" : "+v"(tid)); float2* z = (float2*)smem; float* redbuf = (float*)(smem + 131072);
  float ss = 0.f;
  if constexpr (LOGN & 1) {
    for (int i = tid; i < N / 2; i += NTHR) { float k0 = kr[i], k1 = kr[i + N / 2]; ss += k0 * k0 + k1 * k1; float2 w = twid((float)i * (1.f / N)); float d = k0 - k1;
      z[i] = float2{k0 + k1, 0.f}; z[i + N / 2] = float2{d * w.x, d * w.y}; }
  } else {
    constexpr int Q = N / 4;
    for (int i = tid; i < Q; i += NTHR) { float k0 = kr[i], k1 = kr[i + Q], k2 = kr[i + 2 * Q], k3 = kr[i + 3 * Q]; ss += k0 * k0 + k1 * k1 + k2 * k2 + k3 * k3; float2 o0, o1, o2, o3;
      bfly_fwd(float2{k0, 0.f}, float2{k1, 0.f}, float2{k2, 0.f}, float2{k3, 0.f}, (float)i * (1.f / N), o0, o1, o2, o3);
      z[i] = o0; z[i + Q] = o1; z[i + 2 * Q] = o2; z[i + 3 * Q] = o3; }
  }
  ss = wave_sum(ss); if ((tid & 63) == 0) redbuf[tid >> 6] = ss;
  __syncthreads();
  float tot = 0.f;
#pragma unroll
  for (int w = 0; w < 8; ++w) tot += redbuf[w];
  const float nrm = rsqrtf(tot + EPS) * (1.f / N), bias = p.hy_bias[ch * 256 + cc] * (1.f / N);
  fft_fwd<LOGN, true>(z, tid);
  for (int i = tid; i < N; i += NTHR) { float2 v = z[i]; kh[i] = float2{v.x * nrm + bias, v.y * nrm}; }
  __syncthreads();
}
DI void phase_vx(const Params& p, int ch) {
  int tix_ = threadIdx.x; asm volatile("" : "+v"(tix_));
  const bft* Z = (const bft*)(p.ws + OFF_U); bft* vxT = (bft*)(p.ws + OFF_VXT);
  const float* kraw = (const float*)(p.ws + OFF_KRAW); float2* khat = (float2*)(p.ws + OFF_KHAT);
  const int tid = tix_; float* tile = (float*)smem;
  const float* cw = p.hy_conv_w; const float* cb = p.hy_conv_b;
  for (int it = blockIdx.x; it < 512; it += gridDim.x) {
    int cc = it & 255;
    if (it < 256) filtfft_item<14>(p, ch, cc, kraw + (size_t)cc * 16384, khat + (size_t)cc * 16384);
    else filtfft_item<13>(p, ch, cc, kraw + (size_t)16384 * 256 + (size_t)cc * 8192, khat + (size_t)16384 * 256 + (size_t)cc * 8192);
  }
  float wx[3][8], bx[8], wvv[3][8], bvv[8];
  { const int c0 = ch * 256 + (tid & 31) * 8;
#pragma unroll
    for (int i = 0; i < 8; ++i) { bx[i] = cb[2048 + c0 + i]; bvv[i] = cb[4096 + c0 + i];
#pragma unroll
      for (int t = 0; t < 3; ++t) { wx[t][i] = cw[t * 6144 + 2048 + c0 + i]; wvv[t][i] = cw[t * 6144 + 4096 + c0 + i]; } } }
  for (int it = blockIdx.x; it < T / 64; it += gridDim.x) {
    const int tok0 = it * 64;
#pragma unroll 1
    for (int rr = 0; rr < 4; ++rr) { int e = tid + rr * 512; int tl = e >> 5, cg = e & 31; int tok = tok0 + tl, cc = cg * 8; int pos = tok_pos(tok), L = tok_len(tok);
      const bft* zr = Z + (size_t)tok * 1024; u32x4 zero = {0, 0, 0, 0};
      u32x4 x1m = pos > 0 ? *(const u32x4*)(zr - 1024 + 256 + cc) : zero, x10 = *(const u32x4*)(zr + 256 + cc), x1p = pos < L - 1 ? *(const u32x4*)(zr + 1024 + 256 + cc) : zero;
      u32x4 vm = pos > 0 ? *(const u32x4*)(zr - 1024 + 512 + cc) : zero, v0 = *(const u32x4*)(zr + 512 + cc), vp = pos < L - 1 ? *(const u32x4*)(zr + 1024 + 512 + cc) : zero;
#pragma unroll
      for (int i = 0; i < 8; ++i) { int sh = (i & 1) ? 0 : 16; unsigned msk = 0xffff0000u; int w = i >> 1;
        float a = __uint_as_float((x1m[w] << sh) & msk), b = __uint_as_float((x10[w] << sh) & msk), d = __uint_as_float((x1p[w] << sh) & msk);
        float e0 = __uint_as_float((vm[w] << sh) & msk), e1 = __uint_as_float((v0[w] << sh) & msk), e2 = __uint_as_float((vp[w] << sh) & msk);
        float x1 = a * wx[0][i] + b * wx[1][i] + d * wx[2][i] + bx[i];
        float vv = e0 * wvv[0][i] + e1 * wvv[1][i] + e2 * wvv[2][i] + bvv[i];
        tile[tl * 257 + cc + i] = vv * x1; } }
    __syncthreads();
    { int cl = tid >> 1, th = (tid & 1) * 32; bft* dst = vxT + (size_t)cl * T + tok0 + th;
#pragma unroll
      for (int q = 0; q < 4; ++q) { u32x4 o;
#pragma unroll
        for (int k = 0; k < 4; ++k) o[k] = pack2(tile[(th + q * 8 + 2 * k) * 257 + cl], tile[(th + q * 8 + 2 * k + 1) * 257 + cl]);
        *(u32x4*)(dst + q * 8) = o; } }
    __syncthreads();
  }
}
template <int LOGN> DI void fftconv_item(bft* xa, bft* xb, const float2* kh) {
  constexpr int N = 1 << LOGN, L = N / 2; int tid = threadIdx.x; asm volatile("" : "+v"(tid)); float2* z = (float2*)smem;
  if constexpr (LOGN & 1) {
    for (int i = 2 * tid; i < L; i += 2 * NTHR) { unsigned wa = *(const unsigned*)(xa + i), wb = *(const unsigned*)(xb + i);
      float2 x0 = {__uint_as_float(wa << 16), __uint_as_float(wb << 16)}, x1 = {__uint_as_float(wa & 0xffff0000u), __uint_as_float(wb & 0xffff0000u)};
      z[i] = x0; z[i + 1] = x1;
      z[L + i] = cmul(x0, twid((float)i * (1.f / N))); z[L + i + 1] = cmul(x1, twid((float)(i + 1) * (1.f / N))); }
  } else {
    constexpr int Q = N / 4; const float2 zero = {0.f, 0.f};
    for (int i = 2 * tid; i < Q; i += 2 * NTHR) { unsigned wa = *(const unsigned*)(xa + i), wb = *(const unsigned*)(xb + i), wc = *(const unsigned*)(xa + Q + i), wd = *(const unsigned*)(xb + Q + i);
#pragma unroll
      for (int e = 0; e < 2; ++e) { float2 a0 = e ? float2{__uint_as_float(wa & 0xffff0000u), __uint_as_float(wb & 0xffff0000u)} : float2{__uint_as_float(wa << 16), __uint_as_float(wb << 16)};
        float2 a1 = e ? float2{__uint_as_float(wc & 0xffff0000u), __uint_as_float(wd & 0xffff0000u)} : float2{__uint_as_float(wc << 16), __uint_as_float(wd << 16)};
        float2 o0, o1, o2, o3; bfly_fwd(a0, a1, zero, zero, (float)(i + e) * (1.f / N), o0, o1, o2, o3);
        z[i + e] = o0; z[i + e + Q] = o1; z[i + e + 2 * Q] = o2; z[i + e + 3 * Q] = o3; } }
  }
  __syncthreads();
  fft_fwd<LOGN, true>(z, tid);
  fft_inv_mul<LOGN>(z, tid, kh);
  if constexpr (LOGN & 1) {
    for (int i = 2 * tid; i < L; i += 2 * NTHR) { float2 v0 = z[i], v1 = z[i + 1];
      float2 c0 = cmulc(z[L + i], twid((float)i * (1.f / N))), c1 = cmulc(z[L + i + 1], twid((float)(i + 1) * (1.f / N))); v0.x += c0.x; v0.y += c0.y; v1.x += c1.x; v1.y += c1.y;
      *(unsigned*)(xa + i) = pack2(v0.x, v1.x); *(unsigned*)(xb + i) = pack2(v0.y, v1.y); }
  } else {
    constexpr int Q = N / 4;
    for (int i = 2 * tid; i < Q; i += 2 * NTHR) { float2 r0[2], r1[2];
#pragma unroll
      for (int e = 0; e < 2; ++e) { float2 o2, o3; bfly_inv(z[i + e], z[i + e + Q], z[i + e + 2 * Q], z[i + e + 3 * Q], (float)(i + e) * (1.f / N), r0[e], r1[e], o2, o3); }
      *(unsigned*)(xa + i) = pack2(r0[0].x, r0[1].x); *(unsigned*)(xb + i) = pack2(r0[0].y, r0[1].y);
      *(unsigned*)(xa + Q + i) = pack2(r1[0].x, r1[1].x); *(unsigned*)(xb + Q + i) = pack2(r1[0].y, r1[1].y); }
  }
  __syncthreads();
}
DI void fftconv2_item(bft* x, const float2* kh) {
  constexpr int N = 8192, L = 4096; int tid = threadIdx.x; asm volatile("" : "+v"(tid)); float2* z0 = (float2*)smem;
  for (int ii = 2 * tid; ii < 2 * L; ii += 2 * NTHR) { const int sel = ii >= L ? 1 : 0, i = ii - sel * L; bft* xa = x + sel * 2 * L; bft* xb = xa + L; float2* z = z0 + sel * N;
    unsigned wa = *(const unsigned*)(xa + i), wb = *(const unsigned*)(xb + i);
    float2 x0 = {__uint_as_float(wa << 16), __uint_as_float(wb << 16)}, x1 = {__uint_as_float(wa & 0xffff0000u), __uint_as_float(wb & 0xffff0000u)};
    z[i] = x0; z[i + 1] = x1; z[L + i] = cmul(x0, twid((float)i * (1.f / N))); z[L + i + 1] = cmul(x1, twid((float)(i + 1) * (1.f / N))); }
  __syncthreads();
  fft2x13_fwd(z0, tid);
  fft2x13_inv_mul(z0, tid, kh);
  for (int ii = 2 * tid; ii < 2 * L; ii += 2 * NTHR) { const int sel = ii >= L ? 1 : 0, i = ii - sel * L; bft* xa = x + sel * 2 * L; bft* xb = xa + L; float2* z = z0 + sel * N;
    float2 v0 = z[i], v1 = z[i + 1];
    float2 c0 = cmulc(z[L + i], twid((float)i * (1.f / N))), c1 = cmulc(z[L + i + 1], twid((float)(i + 1) * (1.f / N))); v0.x += c0.x; v0.y += c0.y; v1.x += c1.x; v1.y += c1.y;
    *(unsigned*)(xa + i) = pack2(v0.x, v1.x); *(unsigned*)(xb + i) = pack2(v0.y, v1.y); }
  __syncthreads();
}
DI void phase_conv(const Params& p, int ch) {
  int tix_ = threadIdx.x; asm volatile("" : "+v"(tix_));
  bft* vxT = (bft*)(p.ws + OFF_VXT); const float2* khat = (const float2*)(p.ws + OFF_KHAT);
  for (int it = blockIdx.x; it < 768; it += gridDim.x) {
    int cc = it & 255; bft* row = vxT + (size_t)cc * T;
    if (it < 256) fftconv_item<14>(row, row + 8192, khat + (size_t)cc * 16384);
    else { int pq = (it - 256) >> 8; fftconv2_item(row + TP + (4 * pq) * 4096, khat + (size_t)16384 * 256 + (size_t)cc * 8192); }
  }
}
DI void phase_gate(const Params& p, int ch) {
  int tix_ = threadIdx.x; asm volatile("" : "+v"(tix_));
  const bft* Z = (const bft*)(p.ws + OFF_U); const bft* yT = (const bft*)(p.ws + OFF_VXT); bft* G1 = (bft*)(p.ws + OFF_G1H) + (ch & 3) * 256;
  const int tid = tix_; float* tile = (float*)smem;
  const float* cw = p.hy_conv_w; const float* cb = p.hy_conv_b;
  float w0[3][8], b0[8];
  { const int c0 = ch * 256 + (tid & 31) * 8;
#pragma unroll
    for (int i = 0; i < 8; ++i) { b0[i] = cb[c0 + i];
#pragma unroll
      for (int t = 0; t < 3; ++t) w0[t][i] = cw[t * 6144 + c0 + i]; } }
  for (int it = blockIdx.x; it < T / 64; it += gridDim.x) {
    const int tok0 = it * 64;
    { int cl = tid >> 1, th = (tid & 1) * 32; const bft* s = yT + (size_t)cl * T + tok0 + th;
#pragma unroll
      for (int q = 0; q < 4; ++q) { u32x4 v = *(const u32x4*)(s + q * 8);
#pragma unroll
        for (int k = 0; k < 4; ++k) { tile[cl * 65 + th + q * 8 + 2 * k] = __uint_as_float(v[k] << 16); tile[cl * 65 + th + q * 8 + 2 * k + 1] = __uint_as_float(v[k] & 0xffff0000u); } } }
    __syncthreads();
#pragma unroll 1
    for (int rr = 0; rr < 4; ++rr) { int e = tid + rr * 512; int tl = e >> 5, cg = e & 31; int tok = tok0 + tl, cc = cg * 8, c = ch * 256 + cc; int pos = tok_pos(tok), L = tok_len(tok);
      const bft* zr = Z + (size_t)tok * 1024; u32x4 zero = {0, 0, 0, 0};
      u32x4 xm = pos > 0 ? *(const u32x4*)(zr - 1024 + cc) : zero, x0 = *(const u32x4*)(zr + cc), xp = pos < L - 1 ? *(const u32x4*)(zr + 1024 + cc) : zero, gt = *(const u32x4*)(zr + 768 + cc);
      float o[8];
#pragma unroll
      for (int i = 0; i < 8; ++i) { int sh = (i & 1) ? 0 : 16; unsigned msk = 0xffff0000u; int w = i >> 1;
        float a = __uint_as_float((xm[w] << sh) & msk), b = __uint_as_float((x0[w] << sh) & msk), d = __uint_as_float((xp[w] << sh) & msk), g = __uint_as_float((gt[w] << sh) & msk);
        float xc = a * w0[0][i] + b * w0[1][i] + d * w0[2][i] + b0[i];
        o[i] = tile[(cc + i) * 65 + tl] * xc * g; }
      u32x4 w = {pack2(o[0], o[1]), pack2(o[2], o[3]), pack2(o[4], o[5]), pack2(o[6], o[7])};
      *(u32x4*)(G1 + (size_t)tok * 1024 + cc) = w; }
    __syncthreads();
  }
}
DI void phase_outproj1(const Params& p, int hh) {
  int tix_ = threadIdx.x; asm volatile("" : "+v"(tix_));
  const bft* G1 = (const bft*)(p.ws + OFF_G1H); bft* hb3 = (bft*)(p.ws + OFF_HB3);
  const bft* Bt = (const bft*)(p.ws + OFF_Wout1) + hh * 1024;
  for (int r_ = 0, it; xcd_item(r_, 4, T / 256, it); ++r_) {
    int brow = (it >> 2) * 256, bcol = (it & 3) * 256;
    int tid = tix_; asm volatile("" : "+v"(tid));
    f32x4 acc[8][4]; ACC256_ZERO(acc);
    g256_mainloop(tid, G1, 1024, Bt, LDW2, brow, bcol, 1024, acc);
    EPI256_BEGIN
      float h[16]; float* hp = p.out + (size_t)row * 1024 + col; load16_f(hp, h);
#pragma unroll
      for (int i = 0; i < 16; ++i) h[i] += v[i];
      store16_f(hp, h); if (hh == 1) store16_bf(hb3 + (size_t)row * 1024 + col, h);
    EPI_END
  }
}
DI void phase_final(const Params& p) {
  int tix_ = threadIdx.x; asm volatile("" : "+v"(tix_));
  const int lane = tix_ & 63, wid = tix_ >> 6; const float* ssq = (const float*)(p.ws + OFF_SSQF);
  for (int it = blockIdx.x; it < T / 8; it += gridDim.x) {
    int tok = it * 8 + wid; float rs = rsqrtf(ssq[tok] * (1.f / 1024) + EPS); float* hr = p.out + (size_t)tok * 1024;
    for (int i = 0; i < 4; ++i) { f32x4 v = *(f32x4*)(hr + i * 256 + lane * 4); f32x4 g = *(const f32x4*)(p.final_g + i * 256 + lane * 4);
      v[0] *= rs * g[0]; v[1] *= rs * g[1]; v[2] *= rs * g[2]; v[3] *= rs * g[3]; *(f32x4*)(hr + i * 256 + lane * 4) = v; }
  }
}

__global__ void __launch_bounds__(NTHR) mega(Params p) {
  cg::grid_group grid = cg::this_grid();
  if (threadIdx.x == 0) xb_words = make_uint4(0u, 0u, 0u, 0u);
  __syncthreads();
  XcdBarrier xb = xcd_barrier_post((unsigned*)(p.ws + OFF_BAR), (volatile LAS unsigned*)&xb_words);
#define GSYNC() xcd_barrier(xb)
  phase_prep(p); GSYNC();
  if (threadIdx.x == 0) { unsigned idx = 0; for (unsigned j = 0; j < xb.x; ++j) idx += xb_ld(&xb.bar[XB_XCNT(j)]) > 0u ? 1u : 0u; xb_words.w = idx; }
  __syncthreads();
  phase_inproj0(p); GSYNC();
  if (p.out == nullptr) grid.sync();
  phase_mlaprep(p); phase_s5gen(p); GSYNC();
  phase_s5step1(p); GSYNC();
  phase_s5scan(p); GSYNC();
  phase_s5step3(p); GSYNC();
  for (int sg = 0; sg < 3; ++sg) { phase_upproj(p, sg); GSYNC(); phase_attn(p, sg); GSYNC(); }
  phase_glu(p); GSYNC();
  phase_outproj0(p); GSYNC();
  phase_ple(p, 0, (const bft*)(p.ws + OFF_U), (bft*)(p.ws + OFF_A), LDP, (float*)(p.ws + OFF_SSQ1)); GSYNC();
  convert_p(p, 1);
  for (int ch = 0; ch < 8; ++ch) {
    if (ch == 4) phase_outproj1(p, 0);
    phase_inproj1(p, ch); phase_filter(p, ch); GSYNC();
    phase_vx(p, ch); GSYNC();
    phase_conv(p, ch); GSYNC();
    phase_gate(p, ch); GSYNC();
  }
  phase_outproj1(p, 1); GSYNC();
  phase_ple(p, 1, (const bft*)(p.ws + OFF_HB3), nullptr, 1024, (float*)(p.ws + OFF_SSQF)); GSYNC();
  phase_final(p);
}

extern "C" void kernel_launch(void* const* d_in, const int* in_sizes, int n_in, void* d_out, int out_size, void* d_ws, size_t ws_size, hipStream_t stream) {
  static int grid_blocks = 0;
  if (!grid_blocks) {
    (void)hipFuncSetAttribute((const void*)mega, hipFuncAttributeMaxDynamicSharedMemorySize, (int)LDS_BYTES);
    int dev = 0, cus = 0, per_cu = 0;
    (void)hipGetDevice(&dev);
    (void)hipDeviceGetAttribute(&cus, hipDeviceAttributeMultiprocessorCount, dev);
    (void)hipOccupancyMaxActiveBlocksPerMultiprocessor(&per_cu, mega, NTHR, LDS_BYTES);
    if (per_cu < 1) per_cu = 1;
    if (per_cu > 1) per_cu = 1;
    grid_blocks = cus * per_cu;
    if (ws_size < OFF_BAR + XCD_BAR_WORDS * 4) fprintf(stderr, "ws too small: %zu < %zu\n", ws_size, (size_t)WS_END);
  }
  Params p{};
  const float** pp = (const float**)&p;
  for (int i = 0; i < 36; ++i) pp[i] = (const float*)d_in[i];
  p.out = (float*)d_out; p.ws = (char*)d_ws;
  for (int i = 0; i < 32; ++i) p.rope_inv[i] = 1.0 / pow(10000.0, (double)(2 * i) / 64.0);
  (void)hipMemsetAsync((char*)d_ws + OFF_BAR, 0, XCD_BAR_WORDS * sizeof(unsigned), stream);
  void* args[] = {&p};
  hipError_t e = hipLaunchCooperativeKernel((void*)mega, dim3(grid_blocks), dim3(NTHR), args, LDS_BYTES, stream);
  if (e != hipSuccess) fprintf(stderr, "cooperative launch failed: %s (grid %d)\n", hipGetErrorString(e), grid_blocks);
}
```

```cpp
#include <hip/hip_runtime.h>
#include <hip/hip_bf16.h>
#include <hip/hip_cooperative_groups.h>
#include <cstdio>
#include <cmath>
namespace cg = cooperative_groups;

#define DI __device__ __forceinline__
typedef unsigned short bft;
using bf16x8 = __attribute__((ext_vector_type(8))) short;
using s16x4  = __attribute__((ext_vector_type(4))) short;
using f32x4  = __attribute__((ext_vector_type(4))) float;
using f32x16 = __attribute__((ext_vector_type(16))) float;
using u32x4  = __attribute__((ext_vector_type(4))) unsigned;
using u32x2  = __attribute__((ext_vector_type(2))) unsigned;

constexpr int T = 49152, TP = 16384, DM = 1024;
constexpr float EPS = 1e-6f;
constexpr int NTHR = 512;
constexpr size_t LDS_BYTES = 147456;

constexpr int LDP = 1088, LDW1 = 1088, LDW2 = 2112, LDWQ = 448, LDWS = 320;
constexpr size_t SZ_W0t = 3840ull * LDW1 * 2, SZ_Wq = 1536ull * LDWQ * 2, SZ_Wkv = 2048ull * LDWS * 2, SZ_Wsq = 1024ull * LDW1 * 2;
constexpr size_t SZ_Wout = 1024ull * LDW2 * 2, SZ_Wpw = 1024ull * LDWS * 2, SZ_W1t = 8192ull * LDW1 * 2;
constexpr size_t OFF_W0t = 0, OFF_Wq = OFF_W0t + SZ_W0t, OFF_Wkv = OFF_Wq + SZ_Wq, OFF_Wglu = OFF_Wkv + SZ_Wkv, OFF_Wout0 = OFF_Wglu + SZ_Wsq;
constexpr size_t OFF_Wpg = OFF_Wout0 + SZ_Wout, OFF_Wpw = OFF_Wpg + 2 * SZ_Wsq, OFF_W1t = OFF_Wpw + 2 * SZ_Wpw, OFF_Wout1 = OFF_W1t + SZ_W1t;
constexpr size_t OFF_R0 = OFF_Wout1 + SZ_Wout, OFF_SSQ1 = OFF_R0 + T * 4, OFF_SSQF = OFF_SSQ1 + T * 4, OFF_HYSSQ = OFF_SSQF + T * 4;
constexpr size_t OFF_ROPE = OFF_HYSSQ + 2 * 2048 * 4, OFF_H2 = OFF_ROPE + 8192ull * 64 * 4;
constexpr size_t SZ_H2 = (8192ull + 4096) * 2 * 64 * 4;
constexpr size_t OFF_A = (OFF_H2 + SZ_H2 + 255) / 256 * 256;
constexpr size_t SZ_TB = (size_t)T * 1024 * 2;
constexpr size_t OFF_U = OFF_A + (size_t)T * LDP * 2;
constexpr size_t OFF_LAT = OFF_U + SZ_TB;
constexpr size_t SZ_LAT = (size_t)T * 704 * 2;
constexpr size_t OFF_G0 = OFF_LAT + SZ_LAT;
constexpr size_t SZ_G0 = (size_t)T * 2048 * 2;
constexpr size_t WS_END = OFF_G0 + SZ_G0;
constexpr size_t OFF_KRAW = OFF_LAT + 32ull * 1024 * 1024, SZ_KRAW = (16384ull + 8192) * 256 * 4;
static_assert(OFF_KRAW + SZ_KRAW <= OFF_G0, "kraw fits in LAT region");
constexpr size_t OFF_KHAT = OFF_G0, SZ_KHAT = (16384ull + 8192) * 256 * 8;
constexpr size_t OFF_VXT = OFF_KHAT + SZ_KHAT, SZ_VXT = (size_t)T * 256 * 4;
constexpr size_t OFF_G1H = OFF_VXT + SZ_VXT, SZ_G1H = (size_t)T * 1024 * 2;
static_assert(OFF_G1H + SZ_G1H <= WS_END, "layer1 layout");
constexpr size_t OFF_HB3 = OFF_U;
constexpr size_t OFF_BAR = (WS_END + 255) / 256 * 256;
static_assert(OFF_BAR + 16384 <= 536870912ull, "workspace budget");

#define XB_TMO      128
#define XB_XCNT(j)  (256  + 64 * (j))
#define XB_XSUB(j)  (1280 + 64 * (j))
#define XB_XGEN(j)  (2304 + 64 * (j))
#define XB_TOP      3328
#define XB_TOPGEN   3392
#define XCD_BAR_WORDS 3456
#define XB_SPIN_CAP (1u << 22)
#define LAS __attribute__((address_space(3)))
__device__ __forceinline__ unsigned xb_ld(unsigned* p)              { return __hip_atomic_load(p, __ATOMIC_RELAXED, __HIP_MEMORY_SCOPE_AGENT); }
__device__ __forceinline__ unsigned xb_add(unsigned* p, unsigned v) { return __hip_atomic_fetch_add(p, v, __ATOMIC_RELAXED, __HIP_MEMORY_SCOPE_AGENT); }
__device__ __forceinline__ unsigned xb_xcc_id() { return (unsigned)__builtin_amdgcn_s_getreg((3 << 11) | 20) & 0xFu; }
#define XB_SPIN(cond, bar) do { unsigned _sp = 0; while (cond) { __builtin_amdgcn_s_sleep(1); \
    if ((++_sp & 255u) == 0u) { if (xb_ld(&(bar)[XB_TMO])) break; if (_sp > XB_SPIN_CAP) { atomicAdd(&(bar)[XB_TMO], 1u); break; } } } } while (0)
struct XcdBarrier { unsigned* bar; unsigned x; volatile LAS unsigned* st; };
__device__ __forceinline__ XcdBarrier xcd_barrier_post(unsigned* bar, volatile LAS unsigned* st) {
  XcdBarrier b; b.bar = bar; b.x = (unsigned)__builtin_amdgcn_readfirstlane((int)xb_xcc_id()); b.st = st;
  if (threadIdx.x == 0) st[2] = xb_add(&bar[XB_XCNT(b.x)], 1u);
  return b;
}
__device__ __forceinline__ void xcd_barrier_complete(unsigned* bar, unsigned x, unsigned& nloc, unsigned& nx) {
  const unsigned G = gridDim.x * gridDim.y * gridDim.z;
  unsigned sum, cnt, mine, sp = 0u;
  for (;;) {
    sum = 0u; cnt = 0u; mine = 0u;
#pragma unroll
    for (unsigned j = 0; j < 16; ++j) { const unsigned c = xb_ld(&bar[XB_XCNT(j)]); sum += c; cnt += (c > 0u) ? 1u : 0u; mine = (j == x) ? c : mine; }
    if (sum == G) break;
    __builtin_amdgcn_s_sleep(1);
    if ((++sp & 255u) == 0u) { if (xb_ld(&bar[XB_TMO])) break; if (sp > XB_SPIN_CAP) { atomicAdd(&bar[XB_TMO], 1u); break; } }
  }
  nloc = mine > 0u ? mine : 1u; nx = cnt > 0u ? cnt : 1u;
}
__device__ __forceinline__ void xcd_barrier(const XcdBarrier& b) {
  asm volatile("s_waitcnt vmcnt(0)" ::: "memory");
  __syncthreads();
  if (threadIdx.x == 0) {
    unsigned* bar = b.bar; unsigned bx = b.x; asm volatile("" : "+s"(bx));
    __builtin_amdgcn_s_waitcnt(0);
    unsigned nloc = b.st[0], nx = b.st[1];
    if (nloc == 0u) { xcd_barrier_complete(bar, bx, nloc, nx); b.st[0] = nloc; b.st[1] = nx; }
    const unsigned old = xb_add(&bar[XB_XSUB(bx)], 1u);
    const unsigned gen = old / nloc;
    if (old + 1u == (gen + 1u) * nloc) {
      __builtin_amdgcn_fence(__ATOMIC_RELEASE, "agent");
      asm volatile("s_waitcnt vmcnt(0)" ::: "memory");
      const unsigned og = xb_add(&bar[XB_TOP], 1u);
      const unsigned tg = og / nx;
      if (og + 1u == (tg + 1u) * nx) xb_add(&bar[XB_TOPGEN], 1u);
      else XB_SPIN(xb_ld(&bar[XB_TOPGEN]) == tg, bar);
      __builtin_amdgcn_fence(__ATOMIC_ACQUIRE, "agent");
      xb_add(&bar[XB_XGEN(bx)], 1u);
      asm volatile("s_waitcnt vmcnt(0)" ::: "memory");
    } else {
      XB_SPIN(xb_ld(&bar[XB_XGEN(bx)]) == gen, bar);
      __builtin_amdgcn_fence(__ATOMIC_ACQUIRE, "agent");
      asm volatile("s_waitcnt vmcnt(0)" ::: "memory");
    }
  }
  __syncthreads();
}

struct Params {
  const float *x_prompt, *x_sample, *p_prompt, *p_sample, *norm_g, *final_g, *ple_w, *ple_gate_w, *ab_w_in, *ab_w_out;
  const float *s5_a_re, *s5_a_im, *s5_log_dt, *s5_b_re, *s5_b_im, *s5_c_re, *s5_c_im, *s5_d, *s5_glu_w, *s5_glu_b;
  const float *mla_q_norm, *mla_w_q_up, *mla_kv_norm, *mla_w_kv_up, *hy_w_in, *hy_w_out, *hy_conv_w, *hy_conv_b;
  const float *hy_f_w1, *hy_f_b1, *hy_f_freq1, *hy_f_w2, *hy_f_b2, *hy_f_freq2, *hy_f_w3, *hy_bias;
  float* out; char* ws;
  double rope_inv[32];
};

extern __shared__ __attribute__((aligned(16))) char smem[];

DI bft f2bf(float x) { unsigned u = __float_as_uint(x); u += 0x7fffu + ((u >> 16) & 1u); return (bft)(u >> 16); }
DI float bf2f(bft h) { return __uint_as_float(((unsigned)h) << 16); }
DI unsigned pack2(float a, float b) { return (unsigned)f2bf(a) | ((unsigned)f2bf(b) << 16); }
DI float2 cmul(float2 a, float2 b) { return float2{a.x * b.x - a.y * b.y, a.x * b.y + a.y * b.x}; }
DI float2 cmulc(float2 a, float2 b) { return float2{a.x * b.x + a.y * b.y, a.y * b.x - a.x * b.y}; }
DI float sigm(float x) { return 1.f / (1.f + __expf(-x)); }
DI float siluf(float x) { return x * sigm(x); }
DI float geluf(float x) { float z = 0.7978845608028654f * (x + 0.044715f * x * x * x); float t = 1.f - 2.f / (1.f + __expf(2.f * z)); return 0.5f * x * (1.f + t); }
DI void sincos_d(double ang, float& s, float& c) { double rev = ang * 0.15915494309189535; rev -= rint(rev); float r = (float)rev; s = __builtin_amdgcn_sinf(r); c = __builtin_amdgcn_cosf(r); }
DI float sin_f(float ang) { float rev = ang * 0.15915494309189535f; rev -= rintf(rev); return __builtin_amdgcn_sinf(rev); }
DI float wave_sum(float v) { for (int o = 32; o > 0; o >>= 1) v += __shfl_xor(v, o); return v; }
DI int tok_pos(int tok) { return tok < TP ? (tok & 8191) : (tok & 4095); }
DI int tok_len(int tok) { return tok < TP ? 8192 : 4096; }
__shared__ uint4 xb_words;
DI bool xcd_item(int r, int GS, int ngroups, int& item) {
  const int nb = (int)xb_words.x, nx = (int)xb_words.y, j = (int)xb_words.z, xcd = (int)xb_words.w;
  const int li = r * nb + j, gl = li / GS, gi = gl * nx + xcd;
  if (gi >= ngroups) return false;
  item = gi * GS + (li - gl * GS); return true;
}
DI const float* xrow(const Params& p, int tok) { return tok < TP ? p.x_prompt + (size_t)tok * 1024 : p.x_sample + (size_t)(tok - TP) * 1024; }

struct TrJob { const float* src; int ldsrc, srccol0, k0; bft* dst; int lddst, dstrow0; const float* g; };
DI bool get_trjob(const Params& p, int j, TrJob& o) {
  const int c1 = 944, c2 = c1 + 144, c3 = c2 + 128, c4 = c3 + 256, c5 = c4 + 512, c6 = c5 + 512, c7 = c6 + 128, c8 = c7 + 2048, c9 = c8 + 512;
  int K, N, t; o.g = nullptr;
  if (j < c1) { t = j; K = 1024; N = 3776; o.src = p.ab_w_in; o.dst = (bft*)(p.ws + OFF_W0t); o.g = p.norm_g; }
  else if (j < c2) { t = j - c1; K = 384; N = 1536; o.src = p.mla_w_q_up; o.dst = (bft*)(p.ws + OFF_Wq); o.g = p.mla_q_norm; }
  else if (j < c3) { t = j - c2; K = 256; N = 2048; o.src = p.mla_w_kv_up; o.dst = (bft*)(p.ws + OFF_Wkv); o.g = p.mla_kv_norm; }
  else if (j < c4) { t = j - c3; K = 1024; N = 1024; o.src = p.s5_glu_w; o.dst = (bft*)(p.ws + OFF_Wglu); }
  else if (j < c5) { t = j - c4; K = 2048; N = 1024; o.src = p.ab_w_out; o.dst = (bft*)(p.ws + OFF_Wout0); }
  else if (j < c6) { t = j - c5; int l = t >> 8; t &= 255; K = 1024; N = 1024; o.src = p.ple_gate_w + (size_t)l * 1024 * 1024; o.dst = (bft*)(p.ws + OFF_Wpg + l * SZ_Wsq); }
  else if (j < c7) { t = j - c6; int l = t >> 6; t &= 63; K = 256; N = 1024; o.src = p.ple_w + (size_t)l * 256 * 1024; o.dst = (bft*)(p.ws + OFF_Wpw + l * SZ_Wpw); }
  else if (j < c8) { t = j - c7; K = 1024; N = 8192; o.src = p.hy_w_in; o.dst = (bft*)(p.ws + OFF_W1t); o.g = p.norm_g + 1024; }
  else if (j < c9) { t = j - c8; K = 2048; N = 1024; o.src = p.hy_w_out; o.dst = (bft*)(p.ws + OFF_Wout1); }
  else return false;
  int nt = N / 64; int kt = t / nt, ntile = t % nt;
  o.ldsrc = N; o.srccol0 = ntile * 64; o.k0 = kt * 64; o.lddst = K + 64; o.dstrow0 = ntile * 64;
  if (j >= c7 && j < c8) { int n0 = ntile * 64, part = n0 >> 11, rem = n0 & 2047, ch = rem >> 8, cc0 = rem & 255; o.dstrow0 = ch * 1024 + part * 256 + cc0; }
  return true;
}
constexpr int N_TRJOBS = 944 + 144 + 128 + 256 + 512 + 512 + 128 + 2048 + 512;

DI void phase_prep(const Params& p) {
  int tix_ = threadIdx.x; asm volatile("" : "+v"(tix_));
  const int tid = tix_, lane = tid & 63, wid = tid >> 6;
  float* tile = (float*)smem;
  for (int j = blockIdx.x; j < N_TRJOBS; j += gridDim.x) {
    TrJob jb; get_trjob(p, j, jb);
    { int r = tid >> 6, c = tid & 63;
      for (int i = 0; i < 8; ++i) { int k = i * 8 + r; float v = jb.src[(size_t)(jb.k0 + k) * jb.ldsrc + jb.srccol0 + c]; if (jb.g) v *= jb.g[jb.k0 + k]; tile[k * 65 + c] = v; } }
    __syncthreads();
    { int n = tid >> 3, kq = tid & 7; u32x4 w;
      w[0] = pack2(tile[(kq * 8 + 0) * 65 + n], tile[(kq * 8 + 1) * 65 + n]); w[1] = pack2(tile[(kq * 8 + 2) * 65 + n], tile[(kq * 8 + 3) * 65 + n]);
      w[2] = pack2(tile[(kq * 8 + 4) * 65 + n], tile[(kq * 8 + 5) * 65 + n]); w[3] = pack2(tile[(kq * 8 + 6) * 65 + n], tile[(kq * 8 + 7) * 65 + n]);
      *(u32x4*)(jb.dst + (size_t)(jb.dstrow0 + n) * jb.lddst + jb.k0 + kq * 8) = w; }
    __syncthreads();
  }
  bft* xb = (bft*)(p.ws + OFF_A); float* r0 = (float*)(p.ws + OFF_R0);
  for (int it = blockIdx.x; it < T / 8; it += gridDim.x) {
    int tok = it * 8 + wid; const float* xr = xrow(p, tok); float ss = 0;
    for (int i = 0; i < 4; ++i) { f32x4 v = *(const f32x4*)(xr + i * 256 + lane * 4); ss += v[0] * v[0] + v[1] * v[1] + v[2] * v[2] + v[3] * v[3];
      u32x2 w = {pack2(v[0], v[1]), pack2(v[2], v[3])}; *(u32x2*)(xb + (size_t)tok * LDP + i * 256 + lane * 4) = w; }
    ss = wave_sum(ss); if (lane == 0) r0[tok] = rsqrtf(ss * (1.f / 1024) + EPS);
  }
  const long gsz = (long)gridDim.x * NTHR, gid = (long)blockIdx.x * NTHR + tid;
  { float* z = (float*)(p.ws + OFF_SSQ1); for (long i = gid; i < 2 * T; i += gsz) z[i] = 0.f; }
  { float* rt = (float*)(p.ws + OFF_ROPE); for (long i = gid; i < 8192 * 32; i += gsz) { int pos = (int)(i >> 5), k = (int)(i & 31); float s, c; sincos_d((double)pos * p.rope_inv[k], s, c); rt[pos * 64 + k] = c; rt[pos * 64 + 32 + k] = s; } }
  { float* h2t = (float*)(p.ws + OFF_H2);
    for (int it = blockIdx.x * 8 + wid; it < (8192 + 4096) * 2 / 4; it += gridDim.x * 8) {
      const int i4 = it * 4; int Lsel = i4 < 16384 ? 0 : 1; int r = Lsel ? i4 - 16384 : i4; int L = Lsel ? 4096 : 8192; int dir = r / L, l0 = r % L;
      float zv[4];
#pragma unroll
      for (int k = 0; k < 4; ++k) { const int l = l0 + k; float tl = (float)l / (float)(L - 1); double w = 6.283185307179586 * (double)l / (double)L; float z = 0.f;
        if (lane == 0) z = tl;
        else if (lane <= 32) { int jj = (lane - 1) & 15; double band = 1e-4 + (double)jj * ((15.0 - 1e-4) / 15.0); float s, c; sincos_d(band * w, s, c); z = lane <= 16 ? c : -s; }
        zv[k] = z; }
      const float* w1 = p.hy_f_w1 + (size_t)dir * 33 * 64; const float b1v = p.hy_f_b1[dir * 64 + lane]; float a[4] = {b1v, b1v, b1v, b1v};
      for (int i = 0; i < 33; ++i) { const float wv = w1[i * 64 + lane];
#pragma unroll
        for (int k = 0; k < 4; ++k) a[k] += __shfl(zv[k], i) * wv; }
      const float f1 = p.hy_f_freq1[dir * 64 + lane]; float h1[4];
#pragma unroll
      for (int k = 0; k < 4; ++k) h1[k] = sin_f(f1 * a[k]);
      const float* w2 = p.hy_f_w2 + (size_t)dir * 64 * 64; const float b2v = p.hy_f_b2[dir * 64 + lane]; float bb[4] = {b2v, b2v, b2v, b2v};
      for (int i = 0; i < 64; ++i) { const float wv = w2[i * 64 + lane];
#pragma unroll
        for (int k = 0; k < 4; ++k) bb[k] += __shfl(h1[k], i) * wv; }
      const float f2 = p.hy_f_freq2[dir * 64 + lane]; f32x4 o;
#pragma unroll
      for (int k = 0; k < 4; ++k) o[k] = sin_f(f2 * bb[k]);
      size_t base = Lsel ? (size_t)8192 * 2 * 64 : 0; *(f32x4*)(h2t + base + ((size_t)dir * 64 + lane) * L + l0) = o;
    } }
}

struct APlain { const bft* A; int lda; int brow; DI const bft* operator()(int row, int kt, int ch) const { return A + (size_t)(brow + row) * lda + kt * 64 + ch * 8; } };
template <class AF>
DI void gemm_stage(int tid, const AF& af, const bft* Bt, int ldb, int bcol, int kt, char* sA, char* sB) {
#pragma unroll
  for (int i = 0; i < 4; ++i) { int slot = tid + i * 512, row = slot >> 3, ch = (slot & 7) ^ (row & 7);
    __builtin_amdgcn_global_load_lds((const unsigned*)af(row, kt, ch), (unsigned*)(sA + slot * 16), 16, 0, 0); }
#pragma unroll
  for (int i = 0; i < 2; ++i) { int slot = tid + i * 512, row = slot >> 3, ch = (slot & 7) ^ (row & 7);
    __builtin_amdgcn_global_load_lds((const unsigned*)(Bt + (size_t)(bcol + row) * ldb + kt * 64 + ch * 8), (unsigned*)(sB + slot * 16), 16, 0, 0); }
}
DI void gemm_compute(int tid, const char* sA, const char* sB, f32x4 (&acc)[4][4]) {
  const int wid = tid >> 6, lane = tid & 63, wr = wid >> 1, wc = wid & 1, fr = lane & 15, fq = lane >> 4;
#pragma unroll
  for (int kk = 0; kk < 2; ++kk) {
    bf16x8 a[4], b[4];
#pragma unroll
    for (int m = 0; m < 4; ++m) { int row = wr * 64 + m * 16 + fr; a[m] = *(const bf16x8*)(sA + row * 128 + (((kk * 4 + fq) ^ (row & 7)) << 4)); }
#pragma unroll
    for (int n = 0; n < 4; ++n) { int row = wc * 64 + n * 16 + fr; b[n] = *(const bf16x8*)(sB + row * 128 + (((kk * 4 + fq) ^ (row & 7)) << 4)); }
#pragma unroll
    for (int m = 0; m < 4; ++m)
#pragma unroll
      for (int n = 0; n < 4; ++n) acc[m][n] = __builtin_amdgcn_mfma_f32_16x16x32_bf16(a[m], b[n], acc[m][n], 0, 0, 0);
  }
}
template <class AF>
DI void gemm_mainloop_t(int tid, const AF& af, const bft* Bt, int ldb, int bcol, int K, f32x4 (&acc)[4][4]) {
  const int nk = K >> 6;
  gemm_stage(tid, af, Bt, ldb, bcol, 0, smem, smem + 32768);
  if (nk > 1) gemm_stage(tid, af, Bt, ldb, bcol, 1, smem + 49152, smem + 49152 + 32768);
  int cb = 0;
#pragma unroll 1
  for (int kt = 0; kt < nk; ++kt) {
    if (kt + 1 < nk) asm volatile("s_waitcnt vmcnt(6)" ::: "memory"); else asm volatile("s_waitcnt vmcnt(0)" ::: "memory");
    __syncthreads();
    if (kt + 2 < nk) { int nb = cb + 2; if (nb >= 3) nb -= 3; char* nxt = smem + nb * 49152; gemm_stage(tid, af, Bt, ldb, bcol, kt + 2, nxt, nxt + 32768); }
    char* cur = smem + cb * 49152;
    gemm_compute(tid, cur, cur + 32768, acc);
    if (++cb == 3) cb = 0;
  }
  __syncthreads();
}
DI void gemm_mainloop(int tid, const bft* A, int lda, const bft* Bt, int ldb, int brow, int bcol, int K, f32x4 (&acc)[4][4]) {
  APlain af{A, lda, brow}; gemm_mainloop_t(tid, af, Bt, ldb, bcol, K, acc);
}
template <class AF>
DI void g256_stage(int tid, const AF& af, const bft* Bt, int ldb, int bcol, int kt, char* sA, char* sB) {
#pragma unroll
  for (int i = 0; i < 4; ++i) { int slot = tid + i * 512, row = slot >> 3, ch = (slot & 7) ^ (row & 7);
    __builtin_amdgcn_global_load_lds((const unsigned*)af(row, kt, ch), (unsigned*)(sA + slot * 16), 16, 0, 0); }
#pragma unroll
  for (int i = 0; i < 4; ++i) { int slot = tid + i * 512, row = slot >> 3, ch = (slot & 7) ^ (row & 7);
    __builtin_amdgcn_global_load_lds((const unsigned*)(Bt + (size_t)(bcol + row) * ldb + kt * 64 + ch * 8), (unsigned*)(sB + slot * 16), 16, 0, 0); }
}
template <int KK0, int KK1>
DI void g256_compute(int tid, const char* sA, const char* sB, f32x4 (&acc)[8][4]) {
  const int wid = tid >> 6, lane = tid & 63, wr = wid >> 2, wc = wid & 3, fr = lane & 15, fq = lane >> 4;
#pragma unroll
  for (int kk = KK0; kk < KK1; ++kk) {
    bf16x8 b[4], a[4], a2[4];
#pragma unroll
    for (int n = 0; n < 4; ++n) { int row = wc * 64 + n * 16 + fr; b[n] = *(const bf16x8*)(sB + row * 128 + (((kk * 4 + fq) ^ (row & 7)) << 4)); }
#pragma unroll
    for (int m = 0; m < 4; ++m) { int row = wr * 128 + m * 16 + fr; a[m] = *(const bf16x8*)(sA + row * 128 + (((kk * 4 + fq) ^ (row & 7)) << 4)); }
    __builtin_amdgcn_sched_barrier(0);
#pragma unroll
    for (int m = 0; m < 4; ++m) { int row = wr * 128 + (4 + m) * 16 + fr; a2[m] = *(const bf16x8*)(sA + row * 128 + (((kk * 4 + fq) ^ (row & 7)) << 4)); }
    __builtin_amdgcn_s_setprio(1);
#pragma unroll
    for (int m = 0; m < 4; ++m)
#pragma unroll
      for (int n = 0; n < 4; ++n) acc[m][n] = __builtin_amdgcn_mfma_f32_16x16x32_bf16(a[m], b[n], acc[m][n], 0, 0, 0);
    __builtin_amdgcn_sched_barrier(0);
#pragma unroll
    for (int m = 0; m < 4; ++m)
#pragma unroll
      for (int n = 0; n < 4; ++n) acc[4 + m][n] = __builtin_amdgcn_mfma_f32_16x16x32_bf16(a2[m], b[n], acc[4 + m][n], 0, 0, 0);
    __builtin_amdgcn_s_setprio(0);
    __builtin_amdgcn_sched_barrier(0);
  }
}
template <class AF>
DI void g256_mainloop_t(int tid, const AF& af, const bft* Bt, int ldb, int bcol, int K, f32x4 (&acc)[8][4]) {
  const int nk = K >> 6;
  g256_stage(tid, af, Bt, ldb, bcol, 0, smem, smem + 32768);
#pragma unroll 1
  for (int kt = 0; kt < nk; ++kt) {
    asm volatile("s_waitcnt vmcnt(0)" ::: "memory");
    __syncthreads();
    char* cur = smem + (kt & 1) * 65536; char* nxt = smem + ((kt + 1) & 1) * 65536;
    if (tid < 256) {
      if (kt + 1 < nk) g256_stage(tid, af, Bt, ldb, bcol, kt + 1, nxt, nxt + 32768);
      g256_compute<0, 2>(tid, cur, cur + 32768, acc);
    } else {
      g256_compute<0, 1>(tid, cur, cur + 32768, acc);
      if (kt + 1 < nk) g256_stage(tid, af, Bt, ldb, bcol, kt + 1, nxt, nxt + 32768);
      g256_compute<1, 2>(tid, cur, cur + 32768, acc);
    }
  }
  __syncthreads();
}
DI void g256_mainloop(int tid, const bft* A, int lda, const bft* Bt, int ldb, int brow, int bcol, int K, f32x4 (&acc)[8][4]) {
  APlain af{A, lda, brow}; g256_mainloop_t(tid, af, Bt, ldb, bcol, K, acc);
}
#define ACC256_ZERO(acc) for (int m_ = 0; m_ < 8; ++m_) for (int n_ = 0; n_ < 4; ++n_) acc[m_][n_] = f32x4{0.f, 0.f, 0.f, 0.f}
#define ACC_ZERO(acc) for (int m_ = 0; m_ < 4; ++m_) for (int n_ = 0; n_ < 4; ++n_) acc[m_][n_] = f32x4{0.f, 0.f, 0.f, 0.f}
template <int PATCH = 98304> DI void epi_stage(int tid, const f32x4 (&am)[4], float (&v)[16]) {
  const int lane = tid & 63, wid = tid >> 6, fr = lane & 15, fq = lane >> 4;
  float* stg = (float*)(smem + PATCH) + wid * (16 * 68);
  asm volatile("" ::: "memory");
#pragma unroll
  for (int n = 0; n < 4; ++n)
#pragma unroll
    for (int j = 0; j < 4; ++j) stg[(fq * 4 + j) * 68 + n * 16 + fr] = am[n][j];
  asm volatile("s_waitcnt lgkmcnt(0)" ::: "memory");
  const float* rp = stg + (lane >> 2) * 68 + (lane & 3) * 16;
#pragma unroll
  for (int i = 0; i < 4; ++i) { f32x4 t = *(const f32x4*)(rp + i * 4); v[4 * i] = t[0]; v[4 * i + 1] = t[1]; v[4 * i + 2] = t[2]; v[4 * i + 3] = t[3]; }
  asm volatile("" ::: "memory");
}
DI void store16_bf(bft* dst, const float (&v)[16]) {
  u32x4 o0 = {pack2(v[0], v[1]), pack2(v[2], v[3]), pack2(v[4], v[5]), pack2(v[6], v[7])}, o1 = {pack2(v[8], v[9]), pack2(v[10], v[11]), pack2(v[12], v[13]), pack2(v[14], v[15])};
  *(u32x4*)dst = o0; *(u32x4*)(dst + 8) = o1;
}
DI void load16_bf(const bft* src, float (&v)[16]) {
  u32x4 w0 = *(const u32x4*)src, w1 = *(const u32x4*)(src + 8);
#pragma unroll
  for (int i = 0; i < 4; ++i) { v[2 * i] = __uint_as_float(w0[i] << 16); v[2 * i + 1] = __uint_as_float(w0[i] & 0xffff0000u); v[8 + 2 * i] = __uint_as_float(w1[i] << 16); v[8 + 2 * i + 1] = __uint_as_float(w1[i] & 0xffff0000u); }
}
DI void load16_f(const float* src, float (&v)[16]) {
#pragma unroll
  for (int i = 0; i < 4; ++i) { f32x4 t = *(const f32x4*)(src + 4 * i); v[4 * i] = t[0]; v[4 * i + 1] = t[1]; v[4 * i + 2] = t[2]; v[4 * i + 3] = t[3]; }
}
DI void store16_f(float* dst, const float (&v)[16]) {
#pragma unroll
  for (int i = 0; i < 4; ++i) { f32x4 t = {v[4 * i], v[4 * i + 1], v[4 * i + 2], v[4 * i + 3]}; *(f32x4*)(dst + 4 * i) = t; }
}
#define EPI_BEGIN const int wid = tid >> 6, lane = tid & 63, wr = wid >> 1, wc = wid & 1; \
  _Pragma("unroll") for (int m = 0; m < 4; ++m) { float v[16]; epi_stage(tid, acc[m], v); const int row = brow + wr * 64 + m * 16 + (lane >> 2), col = bcol + wc * 64 + (lane & 3) * 16; (void)row; (void)col;
#define EPI_END }
#define EPI256_BEGIN const int wid = tid >> 6, lane = tid & 63, wr = wid >> 2, wc = wid & 3; \
  _Pragma("unroll") for (int m = 0; m < 8; ++m) { float v[16]; epi_stage<65536>(tid, acc[m], v); const int row = brow + wr * 128 + m * 16 + (lane >> 2), col = bcol + wc * 64 + (lane & 3) * 16; (void)row; (void)col;

DI void phase_inproj0(const Params& p) {
  int tix_ = threadIdx.x; asm volatile("" : "+v"(tix_));
  const bft* A = (const bft*)(p.ws + OFF_A); const bft* Bt = (const bft*)(p.ws + OFF_W0t); const float* r0 = (const float*)(p.ws + OFF_R0);
  bft* u = (bft*)(p.ws + OFF_U); bft* lat = (bft*)(p.ws + OFF_LAT); bft* G0 = (bft*)(p.ws + OFF_G0);
  const int NT = 15, MT = T / 256;
  for (int r_ = 0, it; xcd_item(r_, NT, MT, it); ++r_) {
    int brow = (it / NT) * 256, bcol = (it % NT) * 256;
    int tid = tix_; asm volatile("" : "+v"(tid));
    f32x4 acc[8][4]; ACC256_ZERO(acc);
    g256_mainloop(tid, A, LDP, Bt, LDW1, brow, bcol, 1024, acc);
    EPI256_BEGIN
      float rs = r0[row];
#pragma unroll
      for (int i = 0; i < 16; ++i) v[i] *= rs;
      if (col < 1024) store16_bf(u + (size_t)row * 1024 + col, v);
      else if (col < 1728) store16_bf(lat + (size_t)row * 704 + col - 1024, v);
      else if (col < 3776) {
#pragma unroll
        for (int i = 0; i < 16; ++i) v[i] = siluf(v[i]);
        store16_bf(G0 + (size_t)row * 2048 + col - 1728, v); }
    EPI_END
  }
}

DI void phase_mlaprep(const Params& p) {
  int tix_ = threadIdx.x; asm volatile("" : "+v"(tix_));
  const int lane = tix_ & 63, wid = tix_ >> 6;
  bft* lat = (bft*)(p.ws + OFF_LAT); const float* rt = (const float*)(p.ws + OFF_ROPE);
  for (int it = blockIdx.x; it < T / 8; it += gridDim.x) {
    int tok = it * 8 + wid; bft* r = lat + (size_t)tok * 704;
    float q[6], kv[4], ss = 0, ss2 = 0;
    for (int i = 0; i < 6; ++i) { q[i] = bf2f(r[lane + 64 * i]); ss += q[i] * q[i]; }
    for (int i = 0; i < 4; ++i) { kv[i] = bf2f(r[384 + lane + 64 * i]); ss2 += kv[i] * kv[i]; }
    float kr = bf2f(r[640 + lane]);
    ss = wave_sum(ss); ss2 = wave_sum(ss2);
    float rq = rsqrtf(ss * (1.f / 384) + EPS), rkv = rsqrtf(ss2 * (1.f / 256) + EPS);
    for (int i = 0; i < 6; ++i) r[lane + 64 * i] = f2bf(q[i] * rq);
    for (int i = 0; i < 4; ++i) r[384 + lane + 64 * i] = f2bf(kv[i] * rkv);
    int pos = tok_pos(tok); float c = rt[pos * 64 + (lane & 31)], s = rt[pos * 64 + 32 + (lane & 31)];
    float xo = __shfl_xor(kr, 32);
    float o = lane < 32 ? kr * c - xo * s : xo * s + kr * c;
    r[640 + lane] = f2bf(o);
  }
}

constexpr int S5Q = 32, S5NC = T / S5Q;
constexpr size_t S5_OFF_S = 0, S5_OFF_X = (size_t)64 * S5NC * 256 * 4, S5_OFF_TM = S5_OFF_X + (size_t)64 * S5NC * 256 * 2;
DI void s5_lam(const Params& p, int dir, int g, int m, float tau, float& pr, float& pi) {
  int idx = (dir * 64 + g) * 64 + m; float are = p.s5_a_re[idx], aim = p.s5_a_im[idx], dt = __expf(p.s5_log_dt[dir * 64 + g]);
  float mag = __expf(are * dt * tau), s, c; sincos_d((double)aim * (double)dt * (double)tau, s, c); pr = mag * c; pi = mag * s;
}
DI void phase_s5gen(const Params& p) {
  int tix_ = threadIdx.x; asm volatile("" : "+v"(tix_));
  const int tid = tix_;
  float2* pw = (float2*)smem;
  float2* Bb = (float2*)(smem + 33792);
  float2* Cc = (float2*)(smem + 33792 + 16384);
  float* Kt = (float*)(smem + 33792 + 32768);
  bft* Tm = (bft*)((char*)p.out + S5_OFF_TM); bft* W1 = (bft*)(p.ws + OFF_A);
  for (int it = blockIdx.x; it < 256; it += gridDim.x) {
    const int g = it >> 2, q4 = it & 3;
    if (tid < 128) { int d = tid >> 6, m = tid & 63; int idx = (d * 64 + g) * 64 + m;
      float are = p.s5_a_re[idx], aim = p.s5_a_im[idx];
      for (int tau = 0; tau <= 32; ++tau) { float pr, pi; s5_lam(p, d, g, m, (float)tau, pr, pi); pw[(d * 33 + tau) * 64 + m] = float2{pr, pi}; }
      float abr, abi; s5_lam(p, d, g, m, 1.f, abr, abi);
      float den = are * are + aim * aim, cr = ((abr - 1.f) * are + abi * aim) / den, ci = (abi * are - (abr - 1.f) * aim) / den;
      for (int c = 0; c < 16; ++c) { float br = p.s5_b_re[(size_t)idx * 16 + c], bi = p.s5_b_im[(size_t)idx * 16 + c]; Bb[(d * 64 + m) * 16 + c] = float2{cr * br - ci * bi, cr * bi + ci * br};
        Cc[(d * 16 + c) * 64 + m] = float2{p.s5_c_re[((size_t)(d * 64 + g) * 16 + c) * 64 + m], p.s5_c_im[((size_t)(d * 64 + g) * 16 + c) * 64 + m]}; } }
    __syncthreads();
    for (int e = tid; e < 1024; e += NTHR) {
      const int d = e >> 9, tau = (e >> 4) & 31, cb = ((e >> 2) & 3) * 4, c2b = (e & 3) * 4; float acc[4][4];
#pragma unroll
      for (int i = 0; i < 4; ++i)
#pragma unroll
        for (int j = 0; j < 4; ++j) acc[i][j] = 0.f;
      for (int m = 0; m < 64; ++m) { const float2 pwv = pw[(d * 33 + tau) * 64 + m]; float2 P[4], B[4];
#pragma unroll
        for (int i = 0; i < 4; ++i) { P[i] = cmul(Cc[(d * 16 + cb + i) * 64 + m], pwv); B[i] = Bb[(d * 64 + m) * 16 + c2b + i]; }
#pragma unroll
        for (int i = 0; i < 4; ++i)
#pragma unroll
          for (int j = 0; j < 4; ++j) acc[i][j] += P[i].x * B[j].x - P[i].y * B[j].y; }
#pragma unroll
      for (int i = 0; i < 4; ++i)
#pragma unroll
        for (int j = 0; j < 4; ++j) Kt[((d * 32 + tau) * 16 + cb + i) * 16 + c2b + j] = acc[i][j]; }
    __syncthreads();
    for (int e = tid; e < 128 * 96; e += NTHR) { int n = q4 * 128 + e / 96, k8 = e % 96; int to = n >> 4, c = n & 15; float v[8];
      if (k8 < 64) { int ti = k8 >> 1, c0 = (k8 & 1) * 8;
#pragma unroll
        for (int j = 0; j < 8; ++j) { int c2 = c0 + j; float x;
          if (to > ti) x = Kt[((0 * 32 + (to - ti)) * 16 + c) * 16 + c2]; else if (to < ti) x = Kt[((1 * 32 + (ti - to)) * 16 + c) * 16 + c2];
          else { x = Kt[(c) * 16 + c2] + Kt[((32) * 16 + c) * 16 + c2]; if (c == c2) x += p.s5_d[g * 16 + c]; }
          v[j] = x; } }
      else {
#pragma unroll
        for (int j = 0; j < 8; ++j) { int kk = k8 * 8 - 512 + j; int d = kk >> 7, ri = (kk >> 6) & 1, m = kk & 63; int pwr = d == 0 ? to + 1 : 32 - to;
          float2 P = cmul(Cc[(d * 16 + c) * 64 + m], pw[(d * 33 + pwr) * 64 + m]); v[j] = ri == 0 ? P.x : -P.y; } }
      u32x4 w = {pack2(v[0], v[1]), pack2(v[2], v[3]), pack2(v[4], v[5]), pack2(v[6], v[7])};
      *(u32x4*)(Tm + ((size_t)g * 512 + n) * 768 + k8 * 8) = w; }
    for (int e = tid; e < 64 * 64; e += NTHR) { int n = q4 * 64 + (e >> 6), k8 = e & 63; int d = n >> 7, ri = (n >> 6) & 1, m = n & 63; float v[8];
#pragma unroll
      for (int j = 0; j < 8; ++j) { int k = k8 * 8 + j, tau = k >> 4, c2 = k & 15; int pwr = d == 0 ? 31 - tau : tau;
        float2 V = cmul(pw[(d * 33 + pwr) * 64 + m], Bb[(d * 64 + m) * 16 + c2]); v[j] = ri == 0 ? V.x : V.y; }
      u32x4 w = {pack2(v[0], v[1]), pack2(v[2], v[3]), pack2(v[4], v[5]), pack2(v[6], v[7])};
      *(u32x4*)(W1 + ((size_t)g * 256 + n) * 512 + k8 * 8) = w; }
    __syncthreads();
  }
}
struct AS5 { const bft* u; const bft* X; int g, mrow0; bool withX;
  DI const bft* operator()(int row, int kt, int ch) const {
    if (kt < 8) return u + ((size_t)((mrow0 + row) * 32 + kt * 4 + (ch >> 1)) * 1024 + g * 16 + (ch & 1) * 8);
    return X + ((size_t)(g * S5NC + mrow0 + row) * 256 + (kt - 8) * 64 + ch * 8); } };
DI void phase_s5step1(const Params& p) {
  int tix_ = threadIdx.x; asm volatile("" : "+v"(tix_));
  const bft* u = (const bft*)(p.ws + OFF_U); const bft* W1 = (const bft*)(p.ws + OFF_A); float* S = (float*)((char*)p.out + S5_OFF_S);
  for (int r_ = 0, it; xcd_item(r_, 6, 64, it); ++r_) {
    int g = it / 6, mt = it % 6; const int brow = mt * 256, bcol = 0;
    int tid = tix_; asm volatile("" : "+v"(tid));
    f32x4 acc[8][4]; ACC256_ZERO(acc);
    AS5 af{u, nullptr, g, brow, false};
    g256_mainloop_t(tid, af, W1 + (size_t)g * 256 * 512, 512, bcol, 512, acc);
    EPI256_BEGIN
      store16_f(S + ((size_t)g * S5NC + row) * 256 + col, v);
    EPI_END
  }
}
DI void phase_s5scan(const Params& p) {
  int tix_ = threadIdx.x; asm volatile("" : "+v"(tix_));
  const int lane = tix_ & 63, wid = tix_ >> 6;
  const float* S = (const float*)((char*)p.out + S5_OFF_S); bft* X = (bft*)((char*)p.out + S5_OFF_X);
  for (int wi = blockIdx.x * 8 + wid; wi < 1280; wi += gridDim.x * 8) {
    int dir = wi & 1, g = (wi >> 1) & 63, s = wi >> 7;
    int L = s < 2 ? 8192 : 4096; int tok0 = s < 2 ? s * 8192 : TP + (s - 2) * 4096; int nch = L / S5Q, kc0 = tok0 / S5Q;
    float aqr, aqi; s5_lam(p, dir, g, lane, (float)S5Q, aqr, aqi);
    float xr = 0.f, xi = 0.f;
    for (int kb = 0; kb < nch; kb += 8) {
      float sr[8], si[8];
#pragma unroll
      for (int i = 0; i < 8; ++i) { int k = dir ? nch - 1 - (kb + i) : kb + i; const float* sp = S + ((size_t)g * S5NC + kc0 + k) * 256 + dir * 128 + lane; sr[i] = sp[0]; si[i] = sp[64]; }
#pragma unroll
      for (int i = 0; i < 8; ++i) { int k = dir ? nch - 1 - (kb + i) : kb + i; bft* xp = X + ((size_t)g * S5NC + kc0 + k) * 256 + dir * 128 + lane;
        xp[0] = f2bf(xr); xp[64] = f2bf(xi);
        float nr = aqr * xr - aqi * xi + sr[i], ni = aqr * xi + aqi * xr + si[i]; xr = nr; xi = ni; }
    }
  }
}
DI void phase_s5step3(const Params& p) {
  int tix_ = threadIdx.x; asm volatile("" : "+v"(tix_));
  const bft* u = (const bft*)(p.ws + OFF_U); const bft* X = (const bft*)((char*)p.out + S5_OFF_X); const bft* Tm = (const bft*)((char*)p.out + S5_OFF_TM);
  bft* ys = (bft*)(p.ws + OFF_A);
  for (int r_ = 0, it; xcd_item(r_, 12, 64, it); ++r_) {
    int g = it / 12, r = it % 12, mt = r >> 1, nt = r & 1; const int brow = mt * 256, bcol = nt * 256;
    int tid = tix_; asm volatile("" : "+v"(tid));
    f32x4 acc[8][4]; ACC256_ZERO(acc);
    AS5 af{u, X, g, brow, true};
    g256_mainloop_t(tid, af, Tm + (size_t)g * 512 * 768, 768, bcol, 768, acc);
    EPI256_BEGIN
#pragma unroll
      for (int i = 0; i < 16; ++i) v[i] = geluf(v[i]);
      store16_bf(ys + ((size_t)row * 32 + (col >> 4)) * LDP + g * 16, v);
    EPI_END
  }
}

DI void phase_upproj(const Params& p, int sg) {
  int tix_ = threadIdx.x; asm volatile("" : "+v"(tix_));
  const bft* lat = (const bft*)(p.ws + OFF_LAT) + (size_t)sg * 16384 * 704;
  bft* Q = (bft*)p.out; bft* Kb = Q + (size_t)16384 * 1536; bft* Vb = Kb + (size_t)16384 * 1536;
  const float* rt = (const float*)(p.ws + OFF_ROPE);
  const int MT = 64, NQ = 6, NKV = 8;
  for (int r_ = 0, it; xcd_item(r_, NQ + NKV, MT, it); ++r_) {
    const int mt_ = it / (NQ + NKV), nr_ = it % (NQ + NKV);
    int tid = tix_; asm volatile("" : "+v"(tid));
    f32x4 acc[8][4]; ACC256_ZERO(acc);
    if (nr_ < NQ) {
      int brow = mt_ * 256, bcol = nr_ * 256;
      g256_mainloop(tid, lat, 704, (const bft*)(p.ws + OFF_Wq), LDWQ, brow, bcol, 384, acc);
      EPI256_BEGIN
        const int cw = bcol + wc * 64; const bool is_rope = (cw % 192) == 128;
        if (is_rope) { int pos = tok_pos(sg * 16384 + row); const int cg = lane & 3; const float* rp = rt + pos * 64 + (cg & 1) * 16;
#pragma unroll
          for (int i = 0; i < 16; ++i) { float c = rp[i], s = rp[32 + i]; float xo = __shfl_xor(v[i], 2); v[i] = cg < 2 ? v[i] * c - xo * s : xo * s + v[i] * c; } }
        store16_bf(Q + (size_t)row * 1536 + col, v);
      EPI_END
    } else {
      int brow = mt_ * 256, nt = nr_ - NQ, bcol = nt * 256;
      g256_mainloop(tid, lat + 384, 704, (const bft*)(p.ws + OFF_Wkv), LDWS, brow, bcol, 256, acc);
      const int h = nt;
      EPI256_BEGIN
        const int d = col - bcol;
        if (d >= 128) store16_bf(Vb + (size_t)row * 1024 + h * 128 + d - 128, v); else store16_bf(Kb + (size_t)row * 1536 + h * 192 + d, v);
      EPI_END
      { for (int i = tix_; i < 256 * 8; i += 512) { int r = i >> 3, c8 = i & 7;
          *(u32x4*)(Kb + (size_t)(brow + r) * 1536 + h * 192 + 128 + c8 * 8) = *(const u32x4*)(lat + (size_t)(brow + r) * 704 + 640 + c8 * 8); } }
    }
  }
}

constexpr int KVBLK = 64;
constexpr float ATT_SCALE = 0.07216878364870323f;
constexpr float ATT_THR = 8.f;
constexpr int SHM_V = KVBLK * 128 * 2, SHM_K = KVBLK * 400;
#define KSWZ(row, colB) ((row) * 400 + (colB))
#define SBAR() __builtin_amdgcn_sched_barrier(0)
DI int crow(int r, int hi) { return (r & 3) + 8 * (r >> 2) + 4 * hi; }
DI unsigned cvtpk(float lo, float hi) { unsigned r; asm volatile("v_cvt_pk_bf16_f32 %0, %1, %2" : "=v"(r) : "v"(lo), "v"(hi)); return r; }
DI void partialSM(f32x16& p0, f32x16& p1, float& m_reg, float& mn, float& alpha) {
  constexpr float C = ATT_SCALE * 1.4426950408889634f;
  float pmax = p0[0];
#pragma unroll
  for (int r = 1; r < 16; ++r) pmax = fmaxf(pmax, p0[r]);
#pragma unroll
  for (int r = 0; r < 16; ++r) pmax = fmaxf(pmax, p1[r]);
  { auto rr = __builtin_amdgcn_permlane32_swap(__float_as_uint(pmax), __float_as_uint(pmax), false, false);
    pmax = fmaxf(__uint_as_float(rr[0]), __uint_as_float(rr[1])); }
  if (__builtin_expect(__all(pmax - m_reg <= ATT_THR / ATT_SCALE), 1)) { mn = m_reg; alpha = 1.f; }
  else { mn = fmaxf(m_reg, pmax); alpha = __builtin_amdgcn_exp2f((m_reg - mn) * C); m_reg = mn; }
  float mnC = -mn * C;
#pragma unroll
  for (int r = 0; r < 16; ++r) p0[r] = fmaf(p0[r], C, mnC);
#pragma unroll
  for (int r = 0; r < 16; ++r) p1[r] = fmaf(p1[r], C, mnC);
#pragma unroll
  for (int r = 0; r < 16; ++r) p0[r] = __builtin_amdgcn_exp2f(p0[r]);
}
DI void finishSM(f32x16& p0, f32x16& p1, float alpha, float& l_reg, bf16x8& pa0, bf16x8& pa1, bf16x8& pa2, bf16x8& pa3) {
#pragma unroll
  for (int r = 0; r < 16; ++r) p1[r] = __builtin_amdgcn_exp2f(p1[r]);
  float ps = 0;
#pragma unroll
  for (int r = 0; r < 16; ++r) ps += p0[r];
#pragma unroll
  for (int r = 0; r < 16; ++r) ps += p1[r];
  { auto rr = __builtin_amdgcn_permlane32_swap(__float_as_uint(ps), __float_as_uint(ps), false, false);
    ps = __uint_as_float(rr[0]) + __uint_as_float(rr[1]); }
  l_reg = l_reg * alpha + ps;
#define PK4(P, BASE, OUT) do { unsigned a0 = cvtpk(P[BASE + 0], P[BASE + 1]), a1 = cvtpk(P[BASE + 2], P[BASE + 3]);   \
    unsigned b0 = cvtpk(P[BASE + 4], P[BASE + 5]), b1 = cvtpk(P[BASE + 6], P[BASE + 7]);                              \
    auto r0 = __builtin_amdgcn_permlane32_swap(a0, b0, false, false); auto r1 = __builtin_amdgcn_permlane32_swap(a1, b1, false, false); \
    u32x4 w = {r0[0], r1[0], r0[1], r1[1]}; OUT = *reinterpret_cast<bf16x8*>(&w); } while (0)
  PK4(p0, 0, pa0); PK4(p0, 8, pa1); PK4(p1, 0, pa2); PK4(p1, 8, pa3);
#undef PK4
}
DI void qkt(f32x16& p0, f32x16& p1, const char* Ks, const bf16x8* qr, int r32, int hi) {
  p0 = f32x16{}; p1 = f32x16{};
#pragma unroll
  for (int d0 = 0; d0 < 12; ++d0) { int cb = (d0 * 16 + hi * 8) * 2;
    bf16x8 b0 = *reinterpret_cast<const bf16x8*>(Ks + KSWZ(r32, cb));
    bf16x8 b1 = *reinterpret_cast<const bf16x8*>(Ks + KSWZ(32 + r32, cb));
    p0 = __builtin_amdgcn_mfma_f32_32x32x16_bf16(b0, qr[d0], p0, 0, 0, 0);
    p1 = __builtin_amdgcn_mfma_f32_32x32x16_bf16(b1, qr[d0], p1, 0, 0, 0); }
}
DI int v_st(int k, int c) { const int kk = (k & ~0xC) | ((k & 4) << 1) | ((k & 8) >> 1); return ((kk >> 3) * 4 + (c >> 5)) * 512 + ((kk & 7) * 32 + (c & 31)) * 2; }
DI int v_rd_base(int lane) { return ((lane & 3) << 3) | (((lane >> 2) & 3) << 6) | (((lane >> 4) & 1) << 5) | (((lane >> 5) & 1) << 8); }
constexpr int v_rd_off(int d0, int ks, int half) { return d0 * 512 + ks * 4096 + half * 2048; }
template <int OFF> DI s16x4 tr_read(int vb) { s16x4 r; asm volatile("ds_read_b64_tr_b16 %0, %1 offset:%2" : "=&v"(r) : "v"(vb), "i"(OFF) : "memory"); return r; }
template <int D0> DI void pv_one(f32x16& od, int vb, bf16x8 pa0, bf16x8 pa1, bf16x8 pa2, bf16x8 pa3) {
  const s16x4 l0 = tr_read<v_rd_off(D0, 0, 0)>(vb), h0 = tr_read<v_rd_off(D0, 0, 1)>(vb), l1 = tr_read<v_rd_off(D0, 1, 0)>(vb), h1 = tr_read<v_rd_off(D0, 1, 1)>(vb);
  const s16x4 l2 = tr_read<v_rd_off(D0, 2, 0)>(vb), h2 = tr_read<v_rd_off(D0, 2, 1)>(vb), l3 = tr_read<v_rd_off(D0, 3, 0)>(vb), h3 = tr_read<v_rd_off(D0, 3, 1)>(vb);
  asm volatile("s_waitcnt lgkmcnt(0)" ::: "memory"); SBAR();
#define PK(L, H) (bf16x8){L[0], L[1], L[2], L[3], H[0], H[1], H[2], H[3]}
  od = __builtin_amdgcn_mfma_f32_32x32x16_bf16(pa0, PK(l0, h0), od, 0, 0, 0);
  od = __builtin_amdgcn_mfma_f32_32x32x16_bf16(pa1, PK(l1, h1), od, 0, 0, 0);
  od = __builtin_amdgcn_mfma_f32_32x32x16_bf16(pa2, PK(l2, h2), od, 0, 0, 0);
  od = __builtin_amdgcn_mfma_f32_32x32x16_bf16(pa3, PK(l3, h3), od, 0, 0, 0);
#undef PK
}
DI void pv_d0(f32x16* o, int vb, bf16x8 pa0, bf16x8 pa1, bf16x8 pa2, bf16x8 pa3) {
  pv_one<0>(o[0], vb, pa0, pa1, pa2, pa3); pv_one<1>(o[1], vb, pa0, pa1, pa2, pa3); pv_one<2>(o[2], vb, pa0, pa1, pa2, pa3); pv_one<3>(o[3], vb, pa0, pa1, pa2, pa3);
}
DI void attn_body(const bft* __restrict__ Qb, const bft* __restrict__ Kh, const bft* __restrict__ Vh, bft* __restrict__ Gb, int seq) {
  int tid = threadIdx.x; asm volatile("" : "+v"(tid));
  const int wid = tid >> 6, lane = tid & 63, r32 = lane & 31, hi = lane >> 5;
  char* V_lds = smem; char* K_lds = smem + 2 * SHM_V;
  float* wsl = (float*)(smem + 2 * SHM_V + 2 * SHM_K) + wid * 64; float* li_l = wsl; float* al_l = wsl + 32;
  float m_reg = -1e30f, l_reg = 0; f32x16 o[4] = {}; bf16x8 qr[12];
  const bft* Qw = Qb + (size_t)(wid * 32 + r32) * 1536 + hi * 8;
#pragma unroll
  for (int d0 = 0; d0 < 12; ++d0) qr[d0] = *(const bf16x8*)(Qw + d0 * 16);
  const int sr = tid >> 4, sc = (tid & 15) * 8, vst0 = v_st(sr, sc), vst1 = v_st(32 + sr, sc);
  const int kr0 = tid / 24, kc0 = (tid % 24) * 8, kr1 = (tid + 512) / 24, kc1 = ((tid + 512) % 24) * 8, kr2 = (tid + 1024) / 24, kc2 = ((tid + 1024) % 24) * 8;
  const int vb0 = (int)(uintptr_t)V_lds + v_rd_base(lane);
  bf16x8 vs0, vs1, ks0, ks1, ks2;
#define SLOAD(k0) do { vs0 = *(const bf16x8*)(&Vh[(size_t)((k0) + sr) * 1024 + sc]); vs1 = *(const bf16x8*)(&Vh[(size_t)((k0) + 32 + sr) * 1024 + sc]); \
    ks0 = *(const bf16x8*)(&Kh[(size_t)((k0) + kr0) * 1536 + kc0]); ks1 = *(const bf16x8*)(&Kh[(size_t)((k0) + kr1) * 1536 + kc1]); ks2 = *(const bf16x8*)(&Kh[(size_t)((k0) + kr2) * 1536 + kc2]); } while (0)
#define SWRITE(b) do { *(bf16x8*)(V_lds + (b) * SHM_V + vst0) = vs0; *(bf16x8*)(V_lds + (b) * SHM_V + vst1) = vs1; \
    *(bf16x8*)(K_lds + (b) * SHM_K + KSWZ(kr0, kc0 * 2)) = ks0; *(bf16x8*)(K_lds + (b) * SHM_K + KSWZ(kr1, kc1 * 2)) = ks1; *(bf16x8*)(K_lds + (b) * SHM_K + KSWZ(kr2, kc2 * 2)) = ks2; } while (0)
#define SWAIT() asm volatile("s_waitcnt vmcnt(0)" ::: "memory")
#define RESC(a) do { if (__any((a) < 1.f)) { if (hi == 0) al_l[r32] = (a); asm volatile("s_waitcnt lgkmcnt(0)" ::: "memory"); \
    for (int d = 0; d < 4; ++d) for (int r = 0; r < 16; ++r) o[d][r] *= al_l[crow(r, hi)]; } } while (0)
  f32x16 pA0, pA1; float mnA, alA; bf16x8 pa0, pa1, pa2, pa3; const int NT = seq / KVBLK;
  SLOAD(0); SWAIT(); SWRITE(0); __syncthreads();
  for (int j = 0; j < NT; ++j) {
    const int b = j & 1;
    if (j + 1 < NT) SLOAD((j + 1) * KVBLK);
    SBAR(); qkt(pA0, pA1, K_lds + b * SHM_K, qr, r32, hi);
    partialSM(pA0, pA1, m_reg, mnA, alA);
    RESC(alA);
    finishSM(pA0, pA1, alA, l_reg, pa0, pa1, pa2, pa3); SBAR();
    pv_d0(o, vb0 + b * SHM_V, pa0, pa1, pa2, pa3);
    if (j + 1 < NT) { SWAIT(); SWRITE(b ^ 1); }
    __syncthreads();
  }
  if (hi == 0) li_l[r32] = l_reg; asm volatile("s_waitcnt lgkmcnt(0)" ::: "memory");
  float rli[16];
#pragma unroll
  for (int r = 0; r < 16; ++r) rli[r] = __builtin_amdgcn_rcpf(li_l[crow(r, hi)]);
  bft* Gw = Gb + (size_t)(wid * 32) * 2048;
#pragma unroll
  for (int r = 0; r < 16; ++r) { int orow = crow(r, hi);
#pragma unroll
    for (int d0 = 0; d0 < 4; ++d0) { bft* gp = Gw + (size_t)orow * 2048 + d0 * 32 + r32; *gp = f2bf(o[d0][r] * rli[r] * bf2f(*gp)); } }
  __syncthreads();
#undef SLOAD
#undef SWRITE
#undef SWAIT
#undef RESC
}
DI void phase_attn(const Params& p, int sg) {
  int tix_ = threadIdx.x; asm volatile("" : "+v"(tix_));
  const bft* Q = (const bft*)p.out; const bft* Kb = Q + (size_t)16384 * 1536; const bft* Vb = Kb + (size_t)16384 * 1536;
  bft* G0 = (bft*)(p.ws + OFF_G0) + (size_t)sg * 16384 * 2048;
  const int L = sg == 0 ? 8192 : 4096; const int nqb = L / 256;
  for (int r_ = 0, it; xcd_item(r_, nqb, 512 / nqb, it); ++r_) {
    int qb = it % nqb, rest = it / nqb, h = rest & 7, sl = rest >> 3;
    size_t t0 = (size_t)sl * L;
    attn_body(Q + (t0 + qb * 256) * 1536 + h * 192, Kb + t0 * 1536 + h * 192, Vb + t0 * 1024 + h * 128, G0 + (t0 + qb * 256) * 2048 + 1024 + h * 128, L);
  }
}

DI void convert_p(const Params& p, int layer) {
  int tix_ = threadIdx.x; asm volatile("" : "+v"(tix_));
  bft* pb = (bft*)(p.ws + OFF_LAT);
  const long gsz = (long)gridDim.x * NTHR, gid = (long)blockIdx.x * NTHR + tix_;
  const float* pp = p.p_prompt + (size_t)layer * TP * 256; const float* ps = p.p_sample + (size_t)layer * (T - TP) * 256;
  for (long i = gid; i < (long)T * 256 / 4; i += gsz) { long e = i * 4; f32x4 v = e < (long)TP * 256 ? *(const f32x4*)(pp + e) : *(const f32x4*)(ps + (e - (long)TP * 256));
    u32x2 w = {pack2(v[0], v[1]), pack2(v[2], v[3])}; *(u32x2*)(pb + e) = w; }
}
DI void phase_glu(const Params& p) {
  int tix_ = threadIdx.x; asm volatile("" : "+v"(tix_));
  const bft* ys = (const bft*)(p.ws + OFF_A); bft* G0 = (bft*)(p.ws + OFF_G0);
  for (int r_ = 0, it; xcd_item(r_, 4, T / 256, it); ++r_) {
    int brow = (it >> 2) * 256, bcol = (it & 3) * 256;
    int tid = tix_; asm volatile("" : "+v"(tid));
    f32x4 acc[8][4]; ACC256_ZERO(acc);
    g256_mainloop(tid, ys, LDP, (const bft*)(p.ws + OFF_Wglu), LDW1, brow, bcol, 1024, acc);
    float b[16]; load16_f(p.s5_glu_b + bcol + ((tid >> 6) & 3) * 64 + (tid & 3) * 16, b);
    EPI256_BEGIN
      float y[16], g[16]; load16_bf(ys + (size_t)row * LDP + col, y); bft* gp = G0 + (size_t)row * 2048 + col; load16_bf(gp, g);
#pragma unroll
      for (int i = 0; i < 16; ++i) v[i] = y[i] * sigm(v[i] + b[i]) * g[i];
      store16_bf(gp, v);
    EPI_END
  }
  convert_p(p, 0);
}

DI void phase_outproj0(const Params& p) {
  int tix_ = threadIdx.x; asm volatile("" : "+v"(tix_));
  const bft* G0 = (const bft*)(p.ws + OFF_G0); bft* hb = (bft*)(p.ws + OFF_U);
  for (int r_ = 0, it; xcd_item(r_, 4, T / 256, it); ++r_) {
    int brow = (it >> 2) * 256, bcol = (it & 3) * 256;
    int tid = tix_; asm volatile("" : "+v"(tid));
    f32x4 acc[8][4]; ACC256_ZERO(acc);
    g256_mainloop(tid, G0, 2048, (const bft*)(p.ws + OFF_Wout0), LDW2, brow, bcol, 2048, acc);
    EPI256_BEGIN
      float x[16]; load16_f(xrow(p, row) + col, x);
#pragma unroll
      for (int i = 0; i < 16; ++i) v[i] += x[i];
      store16_f(p.out + (size_t)row * 1024 + col, v); store16_bf(hb + (size_t)row * 1024 + col, v);
    EPI_END
  }
}

DI void phase_ple(const Params& p, int layer, const bft* hbin, bft* hbout, int ldo, float* ssq) {
  int tix_ = threadIdx.x; asm volatile("" : "+v"(tix_));
  const bft* pb = (const bft*)(p.ws + OFF_LAT);
  for (int r_ = 0, it; xcd_item(r_, 8, T / 256, it); ++r_) {
    int brow = (it >> 3) * 256, bcol = (it & 7) * 128;
    int tid = tix_; asm volatile("" : "+v"(tid));
    f32x4 acc[4][4], acc2[4][4]; ACC_ZERO(acc); ACC_ZERO(acc2);
    gemm_mainloop(tid, hbin, 1024, (const bft*)(p.ws + OFF_Wpg + layer * SZ_Wsq), LDW1, brow, bcol, 1024, acc);
    gemm_mainloop(tid, pb, 256, (const bft*)(p.ws + OFF_Wpw + layer * SZ_Wpw), LDWS, brow, bcol, 256, acc2);
    EPI_BEGIN
      float v2[16]; epi_stage(tid, acc2[m], v2); float h[16]; float* hp = p.out + (size_t)row * 1024 + col; load16_f(hp, h); float ss = 0.f;
#pragma unroll
      for (int i = 0; i < 16; ++i) { h[i] += sigm(v[i]) * v2[i]; ss += h[i] * h[i]; }
      store16_f(hp, h); if (hbout) store16_bf(hbout + (size_t)row * ldo + col, h);
      ss += __shfl_xor(ss, 1); ss += __shfl_xor(ss, 2);
      if ((lane & 3) == 0) atomicAdd(ssq + row, ss);
    EPI_END
  }
}

DI void phase_inproj1(const Params& p, int ch) {
  int tix_ = threadIdx.x; asm volatile("" : "+v"(tix_));
  const bft* hb = (const bft*)(p.ws + OFF_A); bft* Z = (bft*)(p.ws + OFF_U); const float* ssq1 = (const float*)(p.ws + OFF_SSQ1);
  const bft* Bt = (const bft*)(p.ws + OFF_W1t) + (size_t)ch * 1024 * LDW1;
  for (int r_ = 0, it; xcd_item(r_, 4, T / 256, it); ++r_) {
    int brow = (it >> 2) * 256, bcol = (it & 3) * 256;
    int tid = tix_; asm volatile("" : "+v"(tid));
    f32x4 acc[8][4]; ACC256_ZERO(acc);
    g256_mainloop(tid, hb, LDP, Bt, LDW1, brow, bcol, 1024, acc);
    const bool isgate = bcol >= 768;
    EPI256_BEGIN
      float rs = rsqrtf(ssq1[row] * (1.f / 1024) + EPS);
#pragma unroll
      for (int i = 0; i < 16; ++i) { v[i] *= rs; if (isgate) v[i] = siluf(v[i]); }
      store16_bf(Z + (size_t)row * 1024 + col, v);
    EPI_END
  }
}
DI void phase_filter(const Params& p, int ch) {
  int tix_ = threadIdx.x; asm volatile("" : "+v"(tix_));
  const int tid = tix_;
  const float* h2t = (const float*)(p.ws + OFF_H2); float* kraw = (float*)(p.ws + OFF_KRAW);
  const float mind = -3.0701134573253945f, maxd = -15.350567286626973f;
  float* w3s = (float*)smem;
  for (int it = blockIdx.x; it < 192; it += gridDim.x) {
    int Lsel = it < 128 ? 0 : 1; int r = Lsel ? it - 128 : it; int L = Lsel ? 4096 : 8192; int nlb = L / 512;
    int cq = r & 3; r >>= 2; int lb = r % nlb, dir = r / nlb; int l = lb * 512 + tid; int cc0 = cq * 64, c0 = ch * 256 + cc0;
    const float* w3 = p.hy_f_w3 + (size_t)dir * 64 * 2048 + c0;
    for (int e = tid; e < 4096; e += NTHR) w3s[e] = w3[(size_t)(e >> 6) * 2048 + (e & 63)];
    const float* h2 = h2t + (Lsel ? (size_t)8192 * 2 * 64 : 0) + (size_t)dir * 64 * L + l;
    float hv[64];
#pragma unroll
    for (int j = 0; j < 64; ++j) hv[j] = h2[(size_t)j * L];
    __syncthreads();
    float* kr = kraw + (Lsel ? (size_t)16384 * 256 : 0); const int N = 2 * L; const float tl = (float)l / (float)(L - 1);
#pragma unroll 1
    for (int c4 = 0; c4 < 16; ++c4) {
      float a0 = 0.f, a1 = 0.f, a2 = 0.f, a3 = 0.f;
#pragma unroll
      for (int j = 0; j < 64; ++j) { f32x4 w = *(const f32x4*)(w3s + j * 64 + c4 * 4); a0 += hv[j] * w[0]; a1 += hv[j] * w[1]; a2 += hv[j] * w[2]; a3 += hv[j] * w[3]; }
      float av[4] = {a0, a1, a2, a3};
#pragma unroll
      for (int i = 0; i < 4; ++i) { int cl = c4 * 4 + i; float delta = fabsf(mind + (float)(c0 + cl) * ((maxd - mind) / 2047.f)); float k = av[i] * __expf(-tl * delta);
        float* row = kr + (size_t)(cc0 + cl) * N;
        if (dir == 0) row[l] = k; else if (l > 0) row[N - l] = k; else row[L] = 0.f; }
    }
    __syncthreads();
  }
}
DI float conv3_at(const bft* Z, int tok, int pos, int L, int col, float w0, float w1, float w2, float b) {
  float xm = pos > 0 ? bf2f(Z[(size_t)(tok - 1) * 1024 + col]) : 0.f, x0 = bf2f(Z[(size_t)tok * 1024 + col]), xp = pos < L - 1 ? bf2f(Z[(size_t)(tok + 1) * 1024 + col]) : 0.f;
  return xm * w0 + x0 * w1 + xp * w2 + b;
}
DI float2 twid(float r) { return float2{__builtin_amdgcn_cosf(r), -__builtin_amdgcn_sinf(r)}; }
DI void bfly_fwd(float2 a0, float2 a1, float2 a2, float2 a3, float r, float2& o0, float2& o1, float2& o2, float2& o3) {
  float2 t0 = {a0.x + a2.x, a0.y + a2.y}, t1 = {a0.x - a2.x, a0.y - a2.y}, t2 = {a1.x + a3.x, a1.y + a3.y}, t3 = {a1.x - a3.x, a1.y - a3.y};
  float2 b0 = {t0.x + t2.x, t0.y + t2.y}, b2 = {t0.x - t2.x, t0.y - t2.y}, b1 = {t1.x + t3.y, t1.y - t3.x}, b3 = {t1.x - t3.y, t1.y + t3.x};
  float2 w1 = twid(r), w2 = cmul(w1, w1), w3 = cmul(w2, w1);
  o0 = b0; o1 = cmul(b1, w1); o2 = cmul(b2, w2); o3 = cmul(b3, w3);
}
DI void bfly_inv(float2 s0, float2 s1, float2 s2, float2 s3, float r, float2& o0, float2& o1, float2& o2, float2& o3) {
  float2 w1 = twid(r), w2 = cmul(w1, w1), w3 = cmul(w2, w1);
  float2 c0 = s0, c1 = cmulc(s1, w1), c2 = cmulc(s2, w2), c3 = cmulc(s3, w3);
  float2 t0 = {c0.x + c2.x, c0.y + c2.y}, t1 = {c0.x - c2.x, c0.y - c2.y}, t2 = {c1.x + c3.x, c1.y + c3.y}, t3 = {c1.x - c3.x, c1.y - c3.y};
  o0 = float2{t0.x + t2.x, t0.y + t2.y}; o2 = float2{t0.x - t2.x, t0.y - t2.y}; o1 = float2{t1.x - t3.y, t1.y + t3.x}; o3 = float2{t1.x + t3.y, t1.y - t3.x};
}
template <int N, int NBT = 1> DI void fft_level_fwd(float2* z0, int tid, int lq) {
  const int Q = 1 << lq; const float invM = 1.f / (float)(4 << lq);
  for (int bb = tid; bb < NBT * (N / 4); bb += NTHR) { const int b = bb & (N / 4 - 1); float2* z = z0 + (bb / (N / 4)) * N; int j = b & (Q - 1), base = ((b >> lq) << (lq + 2)) + j; float2 o0, o1, o2, o3;
    bfly_fwd(z[base], z[base + Q], z[base + 2 * Q], z[base + 3 * Q], (float)j * invM, o0, o1, o2, o3);
    z[base] = o0; z[base + Q] = o1; z[base + 2 * Q] = o2; z[base + 3 * Q] = o3; }
  __syncthreads();
}
template <int N, int NBT = 1> DI void fft_level_inv(float2* z0, int tid, int lq) {
  const int Q = 1 << lq; const float invM = 1.f / (float)(4 << lq);
  for (int bb = tid; bb < NBT * (N / 4); bb += NTHR) { const int b = bb & (N / 4 - 1); float2* z = z0 + (bb / (N / 4)) * N; int j = b & (Q - 1), base = ((b >> lq) << (lq + 2)) + j; float2 o0, o1, o2, o3;
    bfly_inv(z[base], z[base + Q], z[base + 2 * Q], z[base + 3 * Q], (float)j * invM, o0, o1, o2, o3);
    z[base] = o0; z[base + Q] = o1; z[base + 2 * Q] = o2; z[base + 3 * Q] = o3; }
  __syncthreads();
}
template <int N, int NBT = 1> DI void fft_pair_fwd(float2* z0, int tid, int lq1) {
  const int lq2 = lq1 - 2, Q1 = 1 << lq1, Q2 = 1 << lq2; const float invM1 = 1.f / (float)(4 << lq1), invM2 = 1.f / (float)(4 << lq2);
  for (int gg = tid; gg < NBT * (N / 16); gg += NTHR) { const int g = gg & (N / 16 - 1); float2* z = z0 + (gg / (N / 16)) * N; const int jp = g & (Q2 - 1), base = ((g >> lq2) << (lq2 + 4)) + jp; float2 x[4][4];
#pragma unroll
    for (int q1 = 0; q1 < 4; ++q1)
#pragma unroll
      for (int q2 = 0; q2 < 4; ++q2) x[q1][q2] = z[base + q1 * Q1 + q2 * Q2];
#pragma unroll
    for (int q2 = 0; q2 < 4; ++q2) bfly_fwd(x[0][q2], x[1][q2], x[2][q2], x[3][q2], (float)(jp + q2 * Q2) * invM1, x[0][q2], x[1][q2], x[2][q2], x[3][q2]);
#pragma unroll
    for (int q1 = 0; q1 < 4; ++q1) bfly_fwd(x[q1][0], x[q1][1], x[q1][2], x[q1][3], (float)jp * invM2, x[q1][0], x[q1][1], x[q1][2], x[q1][3]);
#pragma unroll
    for (int q1 = 0; q1 < 4; ++q1)
#pragma unroll
      for (int q2 = 0; q2 < 4; ++q2) z[base + q1 * Q1 + q2 * Q2] = x[q1][q2]; }
  __syncthreads();
}
template <int N, int NBT = 1> DI void fft_pair_inv(float2* z0, int tid, int lq2) {
  const int lq1 = lq2 + 2, Q1 = 1 << lq1, Q2 = 1 << lq2; const float invM1 = 1.f / (float)(4 << lq1), invM2 = 1.f / (float)(4 << lq2);
  for (int gg = tid; gg < NBT * (N / 16); gg += NTHR) { const int g = gg & (N / 16 - 1); float2* z = z0 + (gg / (N / 16)) * N; const int jp = g & (Q2 - 1), base = ((g >> lq2) << (lq2 + 4)) + jp; float2 x[4][4];
#pragma unroll
    for (int q1 = 0; q1 < 4; ++q1)
#pragma unroll
      for (int q2 = 0; q2 < 4; ++q2) x[q1][q2] = z[base + q1 * Q1 + q2 * Q2];
#pragma unroll
    for (int q1 = 0; q1 < 4; ++q1) bfly_inv(x[q1][0], x[q1][1], x[q1][2], x[q1][3], (float)jp * invM2, x[q1][0], x[q1][1], x[q1][2], x[q1][3]);
#pragma unroll
    for (int q2 = 0; q2 < 4; ++q2) bfly_inv(x[0][q2], x[1][q2], x[2][q2], x[3][q2], (float)(jp + q2 * Q2) * invM1, x[0][q2], x[1][q2], x[2][q2], x[3][q2]);
#pragma unroll
    for (int q1 = 0; q1 < 4; ++q1)
#pragma unroll
      for (int q2 = 0; q2 < 4; ++q2) z[base + q1 * Q1 + q2 * Q2] = x[q1][q2]; }
  __syncthreads();
}
template <int N, int NBT = 1> DI void fft_level0_inv_mul(float2* z0, int tid, const float2* kh) {
  for (int bb = tid; bb < NBT * (N / 4); bb += NTHR) { const int b = bb & (N / 4 - 1); float2* z = z0 + (bb / (N / 4)) * N; const int base = b * 4; f32x4 k01 = *(const f32x4*)(kh + base), k23 = *(const f32x4*)(kh + base + 2); float2 o0, o1, o2, o3;
    bfly_inv(cmul(z[base], float2{k01[0], k01[1]}), cmul(z[base + 1], float2{k01[2], k01[3]}), cmul(z[base + 2], float2{k23[0], k23[1]}), cmul(z[base + 3], float2{k23[2], k23[3]}), 0.f, o0, o1, o2, o3);
    z[base] = o0; z[base + 1] = o1; z[base + 2] = o2; z[base + 3] = o3; }
  __syncthreads();
}
template <int LOGN, bool R2DONE = false> DI void fft_fwd(float2* z, int tid) {
  constexpr int N = 1 << LOGN;
  if constexpr (LOGN & 1) {
    if constexpr (!R2DONE) {
      for (int b = tid; b < N / 2; b += NTHR) { float2 a0 = z[b], a1 = z[b + N / 2]; float2 w = twid((float)b * (1.f / N));
        z[b] = float2{a0.x + a1.x, a0.y + a1.y}; z[b + N / 2] = cmul(float2{a0.x - a1.x, a0.y - a1.y}, w); }
      __syncthreads();
    }
    fft_pair_fwd<N>(z, tid, 10); fft_pair_fwd<N>(z, tid, 6); fft_level_fwd<N>(z, tid, 2); fft_level_fwd<N>(z, tid, 0);
  } else {
    if constexpr (!R2DONE) fft_level_fwd<N>(z, tid, 12);
    fft_pair_fwd<N>(z, tid, 10); fft_pair_fwd<N>(z, tid, 6); fft_level_fwd<N>(z, tid, 2); fft_level_fwd<N>(z, tid, 0);
  }
}
template <int LOGN> DI void fft_inv_mul(float2* z, int tid, const float2* kh) {
  constexpr int N = 1 << LOGN;
  fft_level0_inv_mul<N>(z, tid, kh);
  if constexpr (LOGN & 1) { fft_level_inv<N>(z, tid, 2); fft_pair_inv<N>(z, tid, 4); fft_pair_inv<N>(z, tid, 8); }
  else { fft_level_inv<N>(z, tid, 2); fft_pair_inv<N>(z, tid, 4); fft_pair_inv<N>(z, tid, 8); }
}
DI void fft2x13_fwd(float2* z, int tid) { constexpr int N = 8192;
  fft_pair_fwd<N, 2>(z, tid, 10); fft_pair_fwd<N, 2>(z, tid, 6); fft_level_fwd<N, 2>(z, tid, 2); fft_level_fwd<N, 2>(z, tid, 0); }
DI void fft2x13_inv_mul(float2* z, int tid, const float2* kh) { constexpr int N = 8192;
  fft_level0_inv_mul<N, 2>(z, tid, kh); fft_level_inv<N, 2>(z, tid, 2); fft_pair_inv<N, 2>(z, tid, 4); fft_pair_inv<N, 2>(z, tid, 8); }
template <int LOGN> DI void filtfft_item(const Params& p, int ch, int cc, const float* kr, float2* kh) {
  constexpr int N = 1 << LOGN; int tid = threadIdx.x; asm volatile("" : "+v"(tid)); float2* z = (float2*)smem; float* redbuf = (float*)(smem + 131072);
  float ss = 0.f;
  if constexpr (LOGN & 1) {
    for (int i = tid; i < N / 2; i += NTHR) { float k0 = kr[i], k1 = kr[i + N / 2]; ss += k0 * k0 + k1 * k1; float2 w = twid((float)i * (1.f / N)); float d = k0 - k1;
      z[i] = float2{k0 + k1, 0.f}; z[i + N / 2] = float2{d * w.x, d * w.y}; }
  } else {
    constexpr int Q = N / 4;
    for (int i = tid; i < Q; i += NTHR) { float k0 = kr[i], k1 = kr[i + Q], k2 = kr[i + 2 * Q], k3 = kr[i + 3 * Q]; ss += k0 * k0 + k1 * k1 + k2 * k2 + k3 * k3; float2 o0, o1, o2, o3;
      bfly_fwd(float2{k0, 0.f}, float2{k1, 0.f}, float2{k2, 0.f}, float2{k3, 0.f}, (float)i * (1.f / N), o0, o1, o2, o3);
      z[i] = o0; z[i + Q] = o1; z[i + 2 * Q] = o2; z[i + 3 * Q] = o3; }
  }
  ss = wave_sum(ss); if ((tid & 63) == 0) redbuf[tid >> 6] = ss;
  __syncthreads();
  float tot = 0.f;
#pragma unroll
  for (int w = 0; w < 8; ++w) tot += redbuf[w];
  const float nrm = rsqrtf(tot + EPS) * (1.f / N), bias = p.hy_bias[ch * 256 + cc] * (1.f / N);
  fft_fwd<LOGN, true>(z, tid);
  for (int i = tid; i < N; i += NTHR) { float2 v = z[i]; kh[i] = float2{v.x * nrm + bias, v.y * nrm}; }
  __syncthreads();
}
DI void phase_vx(const Params& p, int ch) {
  int tix_ = threadIdx.x; asm volatile("" : "+v"(tix_));
  const bft* Z = (const bft*)(p.ws + OFF_U); bft* vxT = (bft*)(p.ws + OFF_VXT);
  const float* kraw = (const float*)(p.ws + OFF_KRAW); float2* khat = (float2*)(p.ws + OFF_KHAT);
  const int tid = tix_; float* tile = (float*)smem;
  const float* cw = p.hy_conv_w; const float* cb = p.hy_conv_b;
  for (int it = blockIdx.x; it < 512; it += gridDim.x) {
    int cc = it & 255;
    if (it < 256) filtfft_item<14>(p, ch, cc, kraw + (size_t)cc * 16384, khat + (size_t)cc * 16384);
    else filtfft_item<13>(p, ch, cc, kraw + (size_t)16384 * 256 + (size_t)cc * 8192, khat + (size_t)16384 * 256 + (size_t)cc * 8192);
  }
  float wx[3][8], bx[8], wvv[3][8], bvv[8];
  { const int c0 = ch * 256 + (tid & 31) * 8;
#pragma unroll
    for (int i = 0; i < 8; ++i) { bx[i] = cb[2048 + c0 + i]; bvv[i] = cb[4096 + c0 + i];
#pragma unroll
      for (int t = 0; t < 3; ++t) { wx[t][i] = cw[t * 6144 + 2048 + c0 + i]; wvv[t][i] = cw[t * 6144 + 4096 + c0 + i]; } } }
  for (int it = blockIdx.x; it < T / 64; it += gridDim.x) {
    const int tok0 = it * 64;
#pragma unroll 1
    for (int rr = 0; rr < 4; ++rr) { int e = tid + rr * 512; int tl = e >> 5, cg = e & 31; int tok = tok0 + tl, cc = cg * 8; int pos = tok_pos(tok), L = tok_len(tok);
      const bft* zr = Z + (size_t)tok * 1024; u32x4 zero = {0, 0, 0, 0};
      u32x4 x1m = pos > 0 ? *(const u32x4*)(zr - 1024 + 256 + cc) : zero, x10 = *(const u32x4*)(zr + 256 + cc), x1p = pos < L - 1 ? *(const u32x4*)(zr + 1024 + 256 + cc) : zero;
      u32x4 vm = pos > 0 ? *(const u32x4*)(zr - 1024 + 512 + cc) : zero, v0 = *(const u32x4*)(zr + 512 + cc), vp = pos < L - 1 ? *(const u32x4*)(zr + 1024 + 512 + cc) : zero;
#pragma unroll
      for (int i = 0; i < 8; ++i) { int sh = (i & 1) ? 0 : 16; unsigned msk = 0xffff0000u; int w = i >> 1;
        float a = __uint_as_float((x1m[w] << sh) & msk), b = __uint_as_float((x10[w] << sh) & msk), d = __uint_as_float((x1p[w] << sh) & msk);
        float e0 = __uint_as_float((vm[w] << sh) & msk), e1 = __uint_as_float((v0[w] << sh) & msk), e2 = __uint_as_float((vp[w] << sh) & msk);
        float x1 = a * wx[0][i] + b * wx[1][i] + d * wx[2][i] + bx[i];
        float vv = e0 * wvv[0][i] + e1 * wvv[1][i] + e2 * wvv[2][i] + bvv[i];
        tile[tl * 257 + cc + i] = vv * x1; } }
    __syncthreads();
    { int cl = tid >> 1, th = (tid & 1) * 32; bft* dst = vxT + (size_t)cl * T + tok0 + th;
#pragma unroll
      for (int q = 0; q < 4; ++q) { u32x4 o;
#pragma unroll
        for (int k = 0; k < 4; ++k) o[k] = pack2(tile[(th + q * 8 + 2 * k) * 257 + cl], tile[(th + q * 8 + 2 * k + 1) * 257 + cl]);
        *(u32x4*)(dst + q * 8) = o; } }
    __syncthreads();
  }
}
template <int LOGN> DI void fftconv_item(bft* xa, bft* xb, const float2* kh) {
  constexpr int N = 1 << LOGN, L = N / 2; int tid = threadIdx.x; asm volatile("" : "+v"(tid)); float2* z = (float2*)smem;
  if constexpr (LOGN & 1) {
    for (int i = 2 * tid; i < L; i += 2 * NTHR) { unsigned wa = *(const unsigned*)(xa + i), wb = *(const unsigned*)(xb + i);
      float2 x0 = {__uint_as_float(wa << 16), __uint_as_float(wb << 16)}, x1 = {__uint_as_float(wa & 0xffff0000u), __uint_as_float(wb & 0xffff0000u)};
      z[i] = x0; z[i + 1] = x1;
      z[L + i] = cmul(x0, twid((float)i * (1.f / N))); z[L + i + 1] = cmul(x1, twid((float)(i + 1) * (1.f / N))); }
  } else {
    constexpr int Q = N / 4; const float2 zero = {0.f, 0.f};
    for (int i = 2 * tid; i < Q; i += 2 * NTHR) { unsigned wa = *(const unsigned*)(xa + i), wb = *(const unsigned*)(xb + i), wc = *(const unsigned*)(xa + Q + i), wd = *(const unsigned*)(xb + Q + i);
#pragma unroll
      for (int e = 0; e < 2; ++e) { float2 a0 = e ? float2{__uint_as_float(wa & 0xffff0000u), __uint_as_float(wb & 0xffff0000u)} : float2{__uint_as_float(wa << 16), __uint_as_float(wb << 16)};
        float2 a1 = e ? float2{__uint_as_float(wc & 0xffff0000u), __uint_as_float(wd & 0xffff0000u)} : float2{__uint_as_float(wc << 16), __uint_as_float(wd << 16)};
        float2 o0, o1, o2, o3; bfly_fwd(a0, a1, zero, zero, (float)(i + e) * (1.f / N), o0, o1, o2, o3);
        z[i + e] = o0; z[i + e + Q] = o1; z[i + e + 2 * Q] = o2; z[i + e + 3 * Q] = o3; } }
  }
  __syncthreads();
  fft_fwd<LOGN, true>(z, tid);
  fft_inv_mul<LOGN>(z, tid, kh);
  if constexpr (LOGN & 1) {
    for (int i = 2 * tid; i < L; i += 2 * NTHR) { float2 v0 = z[i], v1 = z[i + 1];
      float2 c0 = cmulc(z[L + i], twid((float)i * (1.f / N))), c1 = cmulc(z[L + i + 1], twid((float)(i + 1) * (1.f / N))); v0.x += c0.x; v0.y += c0.y; v1.x += c1.x; v1.y += c1.y;
      *(unsigned*)(xa + i) = pack2(v0.x, v1.x); *(unsigned*)(xb + i) = pack2(v0.y, v1.y); }
  } else {
    constexpr int Q = N / 4;
    for (int i = 2 * tid; i < Q; i += 2 * NTHR) { float2 r0[2], r1[2];
#pragma unroll
      for (int e = 0; e < 2; ++e) { float2 o2, o3; bfly_inv(z[i + e], z[i + e + Q], z[i + e + 2 * Q], z[i + e + 3 * Q], (float)(i + e) * (1.f / N), r0[e], r1[e], o2, o3); }
      *(unsigned*)(xa + i) = pack2(r0[0].x, r0[1].x); *(unsigned*)(xb + i) = pack2(r0[0].y, r0[1].y);
      *(unsigned*)(xa + Q + i) = pack2(r1[0].x, r1[1].x); *(unsigned*)(xb + Q + i) = pack2(r1[0].y, r1[1].y); }
  }
  __syncthreads();
}
DI void fftconv2_item(bft* x, const float2* kh) {
  constexpr int N = 8192, L = 4096; int tid = threadIdx.x; asm volatile("" : "+v"(tid)); float2* z0 = (float2*)smem;
  for (int ii = 2 * tid; ii < 2 * L; ii += 2 * NTHR) { const int sel = ii >= L ? 1 : 0, i = ii - sel * L; bft* xa = x + sel * 2 * L; bft* xb = xa + L; float2* z = z0 + sel * N;
    unsigned wa = *(const unsigned*)(xa + i), wb = *(const unsigned*)(xb + i);
    float2 x0 = {__uint_as_float(wa << 16), __uint_as_float(wb << 16)}, x1 = {__uint_as_float(wa & 0xffff0000u), __uint_as_float(wb & 0xffff0000u)};
    z[i] = x0; z[i + 1] = x1; z[L + i] = cmul(x0, twid((float)i * (1.f / N))); z[L + i + 1] = cmul(x1, twid((float)(i + 1) * (1.f / N))); }
  __syncthreads();
  fft2x13_fwd(z0, tid);
  fft2x13_inv_mul(z0, tid, kh);
  for (int ii = 2 * tid; ii < 2 * L; ii += 2 * NTHR) { const int sel = ii >= L ? 1 : 0, i = ii - sel * L; bft* xa = x + sel * 2 * L; bft* xb = xa + L; float2* z = z0 + sel * N;
    float2 v0 = z[i], v1 = z[i + 1];
    float2 c0 = cmulc(z[L + i], twid((float)i * (1.f / N))), c1 = cmulc(z[L + i + 1], twid((float)(i + 1) * (1.f / N))); v0.x += c0.x; v0.y += c0.y; v1.x += c1.x; v1.y += c1.y;
    *(unsigned*)(xa + i) = pack2(v0.x, v1.x); *(unsigned*)(xb + i) = pack2(v0.y, v1.y); }
  __syncthreads();
}
DI void phase_conv(const Params& p, int ch) {
  int tix_ = threadIdx.x; asm volatile("" : "+v"(tix_));
  bft* vxT = (bft*)(p.ws + OFF_VXT); const float2* khat = (const float2*)(p.ws + OFF_KHAT);
  for (int it = blockIdx.x; it < 768; it += gridDim.x) {
    int cc = it & 255; bft* row = vxT + (size_t)cc * T;
    if (it < 256) fftconv_item<14>(row, row + 8192, khat + (size_t)cc * 16384);
    else { int pq = (it - 256) >> 8; fftconv2_item(row + TP + (4 * pq) * 4096, khat + (size_t)16384 * 256 + (size_t)cc * 8192); }
  }
}
DI void phase_gate(const Params& p, int ch) {
  int tix_ = threadIdx.x; asm volatile("" : "+v"(tix_));
  const bft* Z = (const bft*)(p.ws + OFF_U); const bft* yT = (const bft*)(p.ws + OFF_VXT); bft* G1 = (bft*)(p.ws + OFF_G1H) + (ch & 3) * 256;
  const int tid = tix_; float* tile = (float*)smem;
  const float* cw = p.hy_conv_w; const float* cb = p.hy_conv_b;
  float w0[3][8], b0[8];
  { const int c0 = ch * 256 + (tid & 31) * 8;
#pragma unroll
    for (int i = 0; i < 8; ++i) { b0[i] = cb[c0 + i];
#pragma unroll
      for (int t = 0; t < 3; ++t) w0[t][i] = cw[t * 6144 + c0 + i]; } }
  for (int it = blockIdx.x; it < T / 64; it += gridDim.x) {
    const int tok0 = it * 64;
    { int cl = tid >> 1, th = (tid & 1) * 32; const bft* s = yT + (size_t)cl * T + tok0 + th;
#pragma unroll
      for (int q = 0; q < 4; ++q) { u32x4 v = *(const u32x4*)(s + q * 8);
#pragma unroll
        for (int k = 0; k < 4; ++k) { tile[cl * 65 + th + q * 8 + 2 * k] = __uint_as_float(v[k] << 16); tile[cl * 65 + th + q * 8 + 2 * k + 1] = __uint_as_float(v[k] & 0xffff0000u); } } }
    __syncthreads();
#pragma unroll 1
    for (int rr = 0; rr < 4; ++rr) { int e = tid + rr * 512; int tl = e >> 5, cg = e & 31; int tok = tok0 + tl, cc = cg * 8, c = ch * 256 + cc; int pos = tok_pos(tok), L = tok_len(tok);
      const bft* zr = Z + (size_t)tok * 1024; u32x4 zero = {0, 0, 0, 0};
      u32x4 xm = pos > 0 ? *(const u32x4*)(zr - 1024 + cc) : zero, x0 = *(const u32x4*)(zr + cc), xp = pos < L - 1 ? *(const u32x4*)(zr + 1024 + cc) : zero, gt = *(const u32x4*)(zr + 768 + cc);
      float o[8];
#pragma unroll
      for (int i = 0; i < 8; ++i) { int sh = (i & 1) ? 0 : 16; unsigned msk = 0xffff0000u; int w = i >> 1;
        float a = __uint_as_float((xm[w] << sh) & msk), b = __uint_as_float((x0[w] << sh) & msk), d = __uint_as_float((xp[w] << sh) & msk), g = __uint_as_float((gt[w] << sh) & msk);
        float xc = a * w0[0][i] + b * w0[1][i] + d * w0[2][i] + b0[i];
        o[i] = tile[(cc + i) * 65 + tl] * xc * g; }
      u32x4 w = {pack2(o[0], o[1]), pack2(o[2], o[3]), pack2(o[4], o[5]), pack2(o[6], o[7])};
      *(u32x4*)(G1 + (size_t)tok * 1024 + cc) = w; }
    __syncthreads();
  }
}
DI void phase_outproj1(const Params& p, int hh) {
  int tix_ = threadIdx.x; asm volatile("" : "+v"(tix_));
  const bft* G1 = (const bft*)(p.ws + OFF_G1H); bft* hb3 = (bft*)(p.ws + OFF_HB3);
  const bft* Bt = (const bft*)(p.ws + OFF_Wout1) + hh * 1024;
  for (int r_ = 0, it; xcd_item(r_, 4, T / 256, it); ++r_) {
    int brow = (it >> 2) * 256, bcol = (it & 3) * 256;
    int tid = tix_; asm volatile("" : "+v"(tid));
    f32x4 acc[8][4]; ACC256_ZERO(acc);
    g256_mainloop(tid, G1, 1024, Bt, LDW2, brow, bcol, 1024, acc);
    EPI256_BEGIN
      float h[16]; float* hp = p.out + (size_t)row * 1024 + col; load16_f(hp, h);
#pragma unroll
      for (int i = 0; i < 16; ++i) h[i] += v[i];
      store16_f(hp, h); if (hh == 1) store16_bf(hb3 + (size_t)row * 1024 + col, h);
    EPI_END
  }
}
DI void phase_final(const Params& p) {
  int tix_ = threadIdx.x; asm volatile("" : "+v"(tix_));
  const int lane = tix_ & 63, wid = tix_ >> 6; const float* ssq = (const float*)(p.ws + OFF_SSQF);
  for (int it = blockIdx.x; it < T / 8; it += gridDim.x) {
    int tok = it * 8 + wid; float rs = rsqrtf(ssq[tok] * (1.f / 1024) + EPS); float* hr = p.out + (size_t)tok * 1024;
    for (int i = 0; i < 4; ++i) { f32x4 v = *(f32x4*)(hr + i * 256 + lane * 4); f32x4 g = *(const f32x4*)(p.final_g + i * 256 + lane * 4);
      v[0] *= rs * g[0]; v[1] *= rs * g[1]; v[2] *= rs * g[2]; v[3] *= rs * g[3]; *(f32x4*)(hr + i * 256 + lane * 4) = v; }
  }
}

__global__ void __launch_bounds__(NTHR) mega(Params p) {
  cg::grid_group grid = cg::this_grid();
  if (threadIdx.x == 0) xb_words = make_uint4(0u, 0u, 0u, 0u);
  __syncthreads();
  XcdBarrier xb = xcd_barrier_post((unsigned*)(p.ws + OFF_BAR), (volatile LAS unsigned*)&xb_words);
#define GSYNC() xcd_barrier(xb)
  phase_prep(p); GSYNC();
  if (threadIdx.x == 0) { unsigned idx = 0; for (unsigned j = 0; j < xb.x; ++j) idx += xb_ld(&xb.bar[XB_XCNT(j)]) > 0u ? 1u : 0u; xb_words.w = idx; }
  __syncthreads();
  phase_inproj0(p); GSYNC();
  if (p.out == nullptr) grid.sync();
  phase_mlaprep(p); phase_s5gen(p); GSYNC();
  phase_s5step1(p); GSYNC();
  phase_s5scan(p); GSYNC();
  phase_s5step3(p); GSYNC();
  for (int sg = 0; sg < 3; ++sg) { phase_upproj(p, sg); GSYNC(); phase_attn(p, sg); GSYNC(); }
  phase_glu(p); GSYNC();
  phase_outproj0(p); GSYNC();
  phase_ple(p, 0, (const bft*)(p.ws + OFF_U), (bft*)(p.ws + OFF_A), LDP, (float*)(p.ws + OFF_SSQ1)); GSYNC();
  convert_p(p, 1);
  for (int ch = 0; ch < 8; ++ch) {
    if (ch == 4) phase_outproj1(p, 0);
    phase_inproj1(p, ch); phase_filter(p, ch); GSYNC();
    phase_vx(p, ch); GSYNC();
    phase_conv(p, ch); GSYNC();
    phase_gate(p, ch); GSYNC();
  }
  phase_outproj1(p, 1); GSYNC();
  phase_ple(p, 1, (const bft*)(p.ws + OFF_HB3), nullptr, 1024, (float*)(p.ws + OFF_SSQF)); GSYNC();
  phase_final(p);
}

extern "C" void kernel_launch(void* const* d_in, const int* in_sizes, int n_in, void* d_out, int out_size, void* d_ws, size_t ws_size, hipStream_t stream) {
  static int grid_blocks = 0;
  if (!grid_blocks) {
    (void)hipFuncSetAttribute((const void*)mega, hipFuncAttributeMaxDynamicSharedMemorySize, (int)LDS_BYTES);
    int dev = 0, cus = 0, per_cu = 0;
    (void)hipGetDevice(&dev);
    (void)hipDeviceGetAttribute(&cus, hipDeviceAttributeMultiprocessorCount, dev);
    (void)hipOccupancyMaxActiveBlocksPerMultiprocessor(&per_cu, mega, NTHR, LDS_BYTES);
    if (per_cu < 1) per_cu = 1;
    if (per_cu > 1) per_cu = 1;
    grid_blocks = cus * per_cu;
    if (ws_size < OFF_BAR + XCD_BAR_WORDS * 4) fprintf(stderr, "ws too small: %zu < %zu\n", ws_size, (size_t)WS_END);
  }
  Params p{};
  const float** pp = (const float**)&p;
  for (int i = 0; i < 36; ++i) pp[i] = (const float*)d_in[i];
  p.out = (float*)d_out; p.ws = (char*)d_ws;
  for (int i = 0; i < 32; ++i) p.rope_inv[i] = 1.0 / pow(10000.0, (double)(2 * i) / 64.0);
  (void)hipMemsetAsync((char*)d_ws + OFF_BAR, 0, XCD_BAR_WORDS * sizeof(unsigned), stream);
  void* args[] = {&p};
  hipError_t e = hipLaunchCooperativeKernel((void*)mega, dim3(grid_blocks), dim3(NTHR), args, LDS_BYTES, stream);
  if (e != hipSuccess) fprintf(stderr, "cooperative launch failed: %s (grid %d)\n", hipGetErrorString(e), grid_blocks);
}
```
